# Optimizing an MI355X kernel written in HIP

```python
import math
import jax, jax.numpy as jnp
from jax import lax
import numpy as np

D_MODEL = 1024
BATCH = 4
SEQ = 8192
DEPTH = 2

CHUNK = 64
LEFT_CHUNKS = 8
BAND_CHUNKS = LEFT_CHUNKS + 1
BAND_LEN = BAND_CHUNKS * CHUNK
HEAD_DIM = 64
MIX_A_WIDTH = D_MODEL // 2
MIX_B_WIDTH = D_MODEL - MIX_A_WIDTH
A_HEADS = MIX_A_WIDTH // HEAD_DIM
MAX_REL = 2 * CHUNK
SSM_GROUP = 16
SSM_GROUPS = MIX_B_WIDTH // SSM_GROUP
SSM_STATE = 64
DT_MIN = 1e-3
DT_MAX = 1e-1
C_WIDTH = D_MODEL
C_HEADS = C_WIDTH // HEAD_DIM
SB_BLOCK = 128
D_FF = -(-8 * D_MODEL // (3 * 256)) * 256
DEEPNORM_ALPHA = (2 * DEPTH) ** 0.25
DEEPNORM_BETA = (8 * DEPTH) ** -0.25
LN_EPS = 1e-5
N_EVEN = (DEPTH + 1) // 2
N_ODD = DEPTH // 2
EVEN_IN = 3 * MIX_A_WIDTH + MIX_B_WIDTH
ODD_IN = 3 * C_WIDTH

kernel_name = "hybrid_chunkattn_s5_stickbreak_deepnorm"


def layer_norm(x, g, b):
    xf = x.astype(jnp.float32)
    mu = jnp.mean(xf, axis=-1, keepdims=True)
    var = jnp.mean(jnp.square(xf - mu), axis=-1, keepdims=True)
    y = (xf - mu) * lax.rsqrt(var + LN_EPS) * g.astype(jnp.float32) + b.astype(jnp.float32)
    return y.astype(x.dtype)


def chunk_band_attention(q, k, v, rel_table):
    b_, s_, _ = q.shape
    n_chunks = s_ // CHUNK

    def heads(t):
        return t.reshape(b_, n_chunks, CHUNK, A_HEADS, HEAD_DIM).transpose(0, 3, 1, 2, 4)

    band = jnp.arange(n_chunks)[:, None] + jnp.arange(BAND_CHUNKS)[None, :]
    valid = jnp.repeat(band >= LEFT_CHUNKS, CHUNK, axis=1)
    q_pos = LEFT_CHUNKS * CHUNK + jnp.arange(CHUNK)
    k_pos = jnp.arange(BAND_LEN)
    rel = jnp.clip(q_pos[:, None] - k_pos[None, :], -MAX_REL, MAX_REL) + MAX_REL
    bias = rel_table[:, rel].astype(jnp.float32)
    scale = HEAD_DIM ** -0.5
    pad = ((0, 0), (LEFT_CHUNKS, 0), (0, 0), (0, 0))

    def one_sequence(args):
        qh, kh, vh = args
        kb = jnp.pad(kh, pad)[:, band].reshape(A_HEADS, n_chunks, BAND_LEN, HEAD_DIM)
        vb = jnp.pad(vh, pad)[:, band].reshape(A_HEADS, n_chunks, BAND_LEN, HEAD_DIM)
        s = jnp.einsum('hcqd,hckd->hcqk', qh, kb).astype(jnp.float32) * scale + bias[:, None]
        s = jnp.where(valid[None, :, None, :], s, -1e30)
        p = jax.nn.softmax(s, axis=-1)
        return jnp.einsum('hcqk,hckd->hcqd', p.astype(vb.dtype), vb)

    o = lax.map(one_sequence, (heads(q), heads(k), heads(v)))
    return o.transpose(0, 2, 3, 1, 4).reshape(b_, s_, MIX_A_WIDTH)


def _complex_affine_combine(e1, e2):
    a1r, a1i, b1r, b1i = e1
    a2r, a2i, b2r, b2i = e2
    ar = a2r * a1r - a2i * a1i
    ai = a2r * a1i + a2i * a1r
    br = a2r * b1r - a2i * b1i + b2r
    bi = a2r * b1i + a2i * b1r + b2i
    return (ar, ai, br, bi)


def s5_mixer(u, lam_re, lam_im, b_re, b_im, c_re, c_im, d_skip, log_dt, glu_w, glu_b):
    b_, s_, _ = u.shape
    f32 = jnp.float32
    ug = u.reshape(b_, s_, SSM_GROUPS, SSM_GROUP).astype(f32)
    dt = jnp.exp(log_dt.astype(f32))[:, None]
    lr = lam_re.astype(f32)
    li = lam_im.astype(f32)
    mag = jnp.exp(lr * dt)
    ar = mag * jnp.cos(li * dt)
    ai = mag * jnp.sin(li * dt)
    den = lr * lr + li * li
    fr = ((ar - 1.0) * lr + ai * li) / den
    fi = (ai * lr - (ar - 1.0) * li) / den
    br_, bi_ = b_re.astype(f32), b_im.astype(f32)
    bbar_r = fr[..., None] * br_ - fi[..., None] * bi_
    bbar_i = fr[..., None] * bi_ + fi[..., None] * br_
    bu_r = jnp.einsum('bsgi,gpi->sbgp', ug, bbar_r)
    bu_i = jnp.einsum('bsgi,gpi->sbgp', ug, bbar_i)
    a_r = jnp.broadcast_to(ar[None, None], (s_, 1, SSM_GROUPS, SSM_STATE))
    a_i = jnp.broadcast_to(ai[None, None], (s_, 1, SSM_GROUPS, SSM_STATE))
    _, _, x_r, x_i = lax.associative_scan(_complex_affine_combine, (a_r, a_i, bu_r, bu_i), axis=0)
    y = (jnp.einsum('sbgp,gip->bsgi', x_r, c_re.astype(f32))
         - jnp.einsum('sbgp,gip->bsgi', x_i, c_im.astype(f32))
         + d_skip.astype(f32) * ug)
    y = jax.nn.gelu(y).reshape(b_, s_, MIX_B_WIDTH)
    y = y * jax.nn.sigmoid(y @ glu_w.astype(f32) + glu_b.astype(f32))
    return y.astype(u.dtype)


def stick_breaking_attention(q, k, v):
    b_, s_, _ = q.shape

    def heads(t):
        return t.reshape(b_, s_, C_HEADS, HEAD_DIM).transpose(0, 2, 1, 3)

    qh, kh, vh = heads(q), heads(k), heads(v)
    scale = HEAD_DIM ** -0.5
    outs = []
    for blk in range(s_ // SB_BLOCK):
        t0 = blk * SB_BLOCK
        end = t0 + SB_BLOCK
        qb = qh[:, :, t0:end]
        kp = kh[:, :, :end]
        vp = vh[:, :, :end]
        z = jnp.einsum('bhqd,bhkd->bhqk', qb, kp).astype(jnp.float32) * scale
        t_idx = t0 + jnp.arange(SB_BLOCK)
        s_idx = jnp.arange(end)
        strict = s_idx[None, :] < t_idx[:, None]
        log_keep = jnp.where(strict, jax.nn.log_sigmoid(-z), 0.0)
        rev = lax.cumsum(log_keep, axis=3, reverse=True)
        after = jnp.concatenate([rev[..., 1:], jnp.zeros_like(rev[..., :1])], axis=-1)
        w = jnp.where(strict, jnp.exp(jax.nn.log_sigmoid(z) + after), 0.0)
        outs.append(jnp.einsum('bhqk,bhkd->bhqd', w.astype(vp.dtype), vp))
    o = jnp.concatenate(outs, axis=2)
    return o.transpose(0, 2, 1, 3).reshape(b_, s_, C_WIDTH)


def swiglu(x, w1, w3, w2):
    return (jax.nn.silu(x @ w1) * (x @ w3)) @ w2


def setup_inputs(seed: int = 0) -> dict:
    key = jax.random.key(seed)
    ks = jax.random.split(key, 24)
    f32 = jnp.float32
    nrm = lambda k, shape, s: jax.random.normal(k, shape, f32) * s
    x = jax.random.normal(ks[0], (BATCH, SEQ, D_MODEL), f32)
    even_w_in = nrm(ks[1], (N_EVEN, D_MODEL, EVEN_IN), D_MODEL ** -0.5)
    even_rel_bias = nrm(ks[2], (N_EVEN, A_HEADS, 2 * MAX_REL + 1), 0.1)
    n_idx = jnp.arange(SSM_STATE, dtype=f32)
    ssm_lambda_re = -0.5 + nrm(ks[3], (N_EVEN, SSM_GROUPS, SSM_STATE), 0.01)
    ssm_lambda_im = jnp.broadcast_to(math.pi * n_idx, (N_EVEN, SSM_GROUPS, SSM_STATE)).astype(f32)
    b_scale = (2 * SSM_GROUP) ** -0.5
    ssm_b_re = nrm(ks[4], (N_EVEN, SSM_GROUPS, SSM_STATE, SSM_GROUP), b_scale)
    ssm_b_im = nrm(ks[5], (N_EVEN, SSM_GROUPS, SSM_STATE, SSM_GROUP), b_scale)
    c_scale = (2 * SSM_STATE) ** -0.5
    ssm_c_re = nrm(ks[6], (N_EVEN, SSM_GROUPS, SSM_GROUP, SSM_STATE), c_scale)
    ssm_c_im = nrm(ks[7], (N_EVEN, SSM_GROUPS, SSM_GROUP, SSM_STATE), c_scale)
    ssm_d = nrm(ks[8], (N_EVEN, SSM_GROUPS, SSM_GROUP), 1.0)
    ssm_log_dt = jax.random.uniform(ks[9], (N_EVEN, SSM_GROUPS), f32, math.log(DT_MIN), math.log(DT_MAX))
    ssm_glu_w = nrm(ks[10], (N_EVEN, MIX_B_WIDTH, MIX_B_WIDTH), MIX_B_WIDTH ** -0.5)
    ssm_glu_b = nrm(ks[11], (N_EVEN, MIX_B_WIDTH), 0.01)
    even_w_out = nrm(ks[12], (N_EVEN, D_MODEL, D_MODEL), DEEPNORM_BETA * D_MODEL ** -0.5)
    odd_w_in = nrm(ks[13], (N_ODD, D_MODEL, ODD_IN), D_MODEL ** -0.5)
    odd_w_out = nrm(ks[14], (N_ODD, C_WIDTH, D_MODEL), DEEPNORM_BETA * C_WIDTH ** -0.5)
    ffn_w1 = nrm(ks[15], (DEPTH, D_MODEL, D_FF), D_MODEL ** -0.5)
    ffn_w3 = nrm(ks[16], (DEPTH, D_MODEL, D_FF), D_MODEL ** -0.5)
    ffn_w2 = nrm(ks[17], (DEPTH, D_FF, D_MODEL), DEEPNORM_BETA * D_FF ** -0.5)
    ln_mix_g = 1.0 + nrm(ks[18], (DEPTH, D_MODEL), 0.01)
    ln_mix_b = nrm(ks[19], (DEPTH, D_MODEL), 0.01)
    ln_ffn_g = 1.0 + nrm(ks[20], (DEPTH, D_MODEL), 0.01)
    ln_ffn_b = nrm(ks[21], (DEPTH, D_MODEL), 0.01)
    return {"x": x, "even_w_in": even_w_in, "even_rel_bias": even_rel_bias,
            "ssm_lambda_re": ssm_lambda_re, "ssm_lambda_im": ssm_lambda_im,
            "ssm_b_re": ssm_b_re, "ssm_b_im": ssm_b_im, "ssm_c_re": ssm_c_re, "ssm_c_im": ssm_c_im,
            "ssm_d": ssm_d, "ssm_log_dt": ssm_log_dt, "ssm_glu_w": ssm_glu_w, "ssm_glu_b": ssm_glu_b,
            "even_w_out": even_w_out, "odd_w_in": odd_w_in, "odd_w_out": odd_w_out,
            "ffn_w1": ffn_w1, "ffn_w3": ffn_w3, "ffn_w2": ffn_w2,
            "ln_mix_g": ln_mix_g, "ln_mix_b": ln_mix_b, "ln_ffn_g": ln_ffn_g, "ln_ffn_b": ln_ffn_b}


def reference(x, even_w_in, even_rel_bias, ssm_lambda_re, ssm_lambda_im, ssm_b_re, ssm_b_im,
              ssm_c_re, ssm_c_im, ssm_d, ssm_log_dt, ssm_glu_w, ssm_glu_b, even_w_out,
              odd_w_in, odd_w_out, ffn_w1, ffn_w3, ffn_w2, ln_mix_g, ln_mix_b, ln_ffn_g, ln_ffn_b):
    h = x
    for layer in range(DEPTH):
        if layer % 2 == 0:
            e = layer // 2
            proj = h @ even_w_in[e]
            qa, ka, va, ub = jnp.split(proj, [MIX_A_WIDTH, 2 * MIX_A_WIDTH, 3 * MIX_A_WIDTH], axis=-1)
            oa = chunk_band_attention(qa, ka, va, even_rel_bias[e])
            ob = s5_mixer(ub, ssm_lambda_re[e], ssm_lambda_im[e], ssm_b_re[e], ssm_b_im[e],
                          ssm_c_re[e], ssm_c_im[e], ssm_d[e], ssm_log_dt[e], ssm_glu_w[e], ssm_glu_b[e])
            mix = jnp.concatenate([oa, ob], axis=-1) @ even_w_out[e]
        else:
            o = layer // 2
            qc, kc, vc = jnp.split(h @ odd_w_in[o], 3, axis=-1)
            mix = stick_breaking_attention(qc, kc, vc) @ odd_w_out[o]
        h = layer_norm(DEEPNORM_ALPHA * h + mix, ln_mix_g[layer], ln_mix_b[layer])
        ffn = swiglu(h, ffn_w1[layer], ffn_w3[layer], ffn_w2[layer])
        h = layer_norm(DEEPNORM_ALPHA * h + ffn, ln_ffn_g[layer], ln_ffn_b[layer])
    return h
```

```cpp
#include <hip/hip_runtime.h>
#include <hip/hip_cooperative_groups.h>
#include <cstdio>
#include <cstdint>
namespace cg = cooperative_groups;
namespace pg8 {
#define PG8_LAS __attribute__((address_space(3)))
typedef unsigned short bf16_t;
typedef short bf16x8 __attribute__((ext_vector_type(8)));
typedef float f32x4 __attribute__((ext_vector_type(4)));
typedef unsigned u32x4 __attribute__((ext_vector_type(4)));
constexpr int BM = 256, BK = 64, HALF = 128, HTB = HALF * BK * 2  , STAGE_BYTES = 8 * HTB, NXCD = 8, WGM = 8;

__host__ __device__ __forceinline__ int lds_byte(int r, int c) { const int st = (r >> 4) * 2 + (c >> 5), rr = r & 15, cc = c & 31, ob = rr * 64 + cc * 2; return st * 1024 + (ob ^ (((ob >> 9) & 1) << 5)); }
__host__ __device__ __forceinline__ void stage_rc(int b, int& R, int& C) { const int st = b / 1024, sb = b % 1024, swz = sb ^ (((sb >> 9) & 1) << 5); R = (st >> 1) * 16 + swz / 64; C = (st & 1) * 32 + (swz % 64) / 2; }
__host__ __device__ __forceinline__ int perm32(int rho) { const int n = rho >> 4, i = rho & 15; return 8 * (i >> 2) + 4 * n + (i & 3); }

struct Unit { int pm, pn; };
struct Gemm { const bf16_t* A; const bf16_t* Bt; int M, N, K; };

struct StaticOrder {
    int nM, nN, nwg, G, c;
    __host__ __device__ void init(int M, int N, int G_, int c_) { nM = M / BM; nN = N / BM; nwg = nM * nN; G = G_; c = c_; }
    __host__ __device__ bool next(int i, Unit& u) const {
        const long L = (long)i * G + c; if (L >= nwg) return false;
        int wgid = (int)L; { const int q = nwg / NXCD, r = nwg % NXCD, xcd = wgid % NXCD, off = wgid / NXCD; wgid = (xcd < r ? xcd * (q + 1) : r * (q + 1) + (xcd - r) * q) + off; }
        const int nig = WGM * nN, gid = wgid / nig, fm = gid * WGM, gsz = (nM - fm) < WGM ? (nM - fm) : WGM;
        u.pm = fm + ((wgid % nig) % gsz); u.pn = (wgid % nig) / gsz; return true;
    }
    __device__ __forceinline__ void a_ready(const Unit&) const {}
    __device__ __forceinline__ void done(const Unit&) const {}
};

__device__ __forceinline__ unsigned cvt_pk_bf16(float lo, float hi) { unsigned r; asm volatile("v_cvt_pk_bf16_f32 %0, %1, %2" : "=v"(r) : "v"(lo), "v"(hi)); return r; }
typedef float f32x2 __attribute__((ext_vector_type(2)));
template <class Epi, class Sched, bool ALIGN_EPI, bool SP2, int KC>
__device__ __forceinline__ void gemm_phase(PG8_LAS unsigned char* lds, const Gemm g, const Sched& S, const Epi& E) {
    int tid_ = threadIdx.x; asm volatile("" : "+v"(tid_)); const int tid = tid_, wid = __builtin_amdgcn_readfirstlane(tid >> 6), lane = tid & 63, wr = wid >> 2, wc = wid & 3, fr = lane & 15, fq = lane >> 4;
    constexpr int K = KC, nt = K / BK;
    unsigned voffA[2], voffB[2];
#pragma unroll
    for (int i = 0; i < 2; ++i) { int R, C; stage_rc(tid * 16 + i * 8192, R, C); const int Rb = Epi::PERM ? ((R & ~31) + perm32(R & 31)) : R;
        voffA[i] = (unsigned)(R * K + C) * 2u; voffB[i] = (unsigned)(Rb * K + C) * 2u; }
    const size_t kstep = (size_t)(BK * 2);
    const size_t hstep = (size_t)HALF * K * 2;
    const size_t tstep = 2 * hstep;
    const unsigned ldsw = (unsigned)wid * 1024u;
    const int aoff = lds_byte(wr * 64 + fr, fq * 8), boff = lds_byte(wc * 32 + fr, fq * 8);
#define PG8_SA(b, h) (((b) * 2 + (h)) * HTB)
#define PG8_SB(b, h) ((4 + (b) * 2 + (h)) * HTB)
#define PG8_STAGE(bufoff, gbase, voff) do { _Pragma("unroll") for (int _i = 0; _i < 2; ++_i) \
        __builtin_amdgcn_global_load_lds((const unsigned*)((const char*)(gbase) + (voff)[_i]), (PG8_LAS unsigned*)(lds + (bufoff) + ldsw + _i * 8192), 16, 0, 0); } while (0)
#define PG8_LDA(dst, b, h) do { _Pragma("unroll") for (int m = 0; m < 4; ++m) _Pragma("unroll") for (int k = 0; k < 2; ++k) dst[m][k] = *(const PG8_LAS bf16x8*)(lds + PG8_SA(b, h) + aoff + m * 2048 + k * 1024); } while (0)
#define PG8_LDB(dst, b, h) do { _Pragma("unroll") for (int n = 0; n < 2; ++n) _Pragma("unroll") for (int k = 0; k < 2; ++k) dst[n][k] = *(const PG8_LAS bf16x8*)(lds + PG8_SB(b, h) + boff + n * 2048 + k * 1024); } while (0)
#define PG8_MMA(ai, bj, At, Bt) do { __builtin_amdgcn_s_setprio(1); _Pragma("unroll") for (int m = 0; m < 4; ++m) _Pragma("unroll") for (int n = 0; n < 2; ++n) _Pragma("unroll") for (int k = 0; k < 2; ++k) \
        acc[ai][bj][m][n] = __builtin_amdgcn_mfma_f32_16x16x32_bf16(Bt[n][k], At[m][k], acc[ai][bj][m][n], 0, 0, 0); __builtin_amdgcn_s_setprio(0); } while (0)
#define PG8_WAIT_V(n) asm volatile("s_waitcnt vmcnt(" #n ")" ::: "memory")
#define PG8_WAIT_L(n) asm volatile("s_waitcnt lgkmcnt(" #n ")" ::: "memory")
#define PG8_BAR __builtin_amdgcn_s_barrier()
#define PG8_SCHED __builtin_amdgcn_sched_barrier(0)
    Unit cur, nxt; int ui = 0;
    if (!S.next(0, cur)) return;
    f32x4 acc[2][2][4][2];
#pragma unroll
    for (int a = 0; a < 2; ++a)
#pragma unroll
        for (int b = 0; b < 2; ++b)
#pragma unroll
            for (int m = 0; m < 4; ++m)
#pragma unroll
                for (int n = 0; n < 2; ++n) acc[a][b][m][n] = (f32x4){0.f, 0.f, 0.f, 0.f};
    bf16x8 At[4][2], B0[2][2], B1[2][2];
    const char* cA = (const char*)g.A + (size_t)cur.pm * tstep; const char* cB = (const char*)g.Bt + (size_t)cur.pn * tstep;
    S.a_ready(cur);
    if constexpr (SP2) {
        PG8_STAGE(PG8_SB(0, 0), cB, voffB); PG8_STAGE(PG8_SB(0, 1), cB + hstep, voffB); PG8_STAGE(PG8_SA(0, 0), cA, voffA); PG8_STAGE(PG8_SA(0, 1), cA + hstep, voffA);
        if (wr == 1) PG8_BAR;
        PG8_WAIT_V(2); PG8_BAR;
        PG8_STAGE(PG8_SB(1, 0), cB + kstep, voffB); PG8_STAGE(PG8_SA(1, 0), cA + kstep, voffA); PG8_STAGE(PG8_SB(1, 1), cB + hstep + kstep, voffB);
        PG8_WAIT_V(6); PG8_BAR;
    } else {
        PG8_STAGE(PG8_SB(0, 0), cB, voffB); PG8_STAGE(PG8_SA(0, 0), cA, voffA); PG8_STAGE(PG8_SB(0, 1), cB + hstep, voffB); PG8_STAGE(PG8_SA(0, 1), cA + hstep, voffA);
        if (wr == 1) PG8_BAR;
        PG8_WAIT_V(4); PG8_BAR;
        PG8_STAGE(PG8_SB(1, 0), cB + kstep, voffB); PG8_STAGE(PG8_SA(1, 0), cA + kstep, voffA); PG8_STAGE(PG8_SB(1, 1), cB + hstep + kstep, voffB);
        PG8_WAIT_V(6); PG8_BAR;
    }
    for (;;) {
        const bool has_next = S.next(ui + 1, nxt);
        const char* nA = has_next ? (const char*)g.A + (size_t)nxt.pm * tstep : cA; const char* nB = has_next ? (const char*)g.Bt + (size_t)nxt.pn * tstep : cB;
        for (int t = 0; t < nt; t += 2) {
            const bool last = (t == nt - 2);
            const char* a1 = cA + (size_t)(t + 1) * kstep;
            const char* a2 = last ? nA : cA + (size_t)(t + 2) * kstep; const char* b2 = last ? nB : cB + (size_t)(t + 2) * kstep;
            const char* a3 = a2 + kstep; const char* b3 = b2 + kstep;
            if (last && has_next) S.a_ready(nxt);
            if constexpr (SP2) {
            PG8_LDB(B0, 0, 0); PG8_LDB(B1, 0, 1); PG8_SCHED; PG8_LDA(At, 0, 0); PG8_STAGE(PG8_SA(1, 1), a1 + hstep, voffA);
            PG8_WAIT_V(8); PG8_WAIT_L(0); PG8_BAR; PG8_MMA(0, 0, At, B0); PG8_MMA(0, 1, At, B1); PG8_BAR; PG8_SCHED;
            PG8_LDA(At, 0, 1); PG8_STAGE(PG8_SB(0, 0), b2, voffB); PG8_STAGE(PG8_SB(0, 1), b2 + hstep, voffB); PG8_STAGE(PG8_SA(0, 0), a2, voffA);
            PG8_WAIT_V(8); PG8_WAIT_L(0); PG8_BAR; PG8_MMA(1, 0, At, B0); PG8_MMA(1, 1, At, B1); PG8_BAR; PG8_SCHED;
            PG8_LDB(B0, 1, 0); PG8_LDB(B1, 1, 1); PG8_SCHED; PG8_LDA(At, 1, 0); PG8_STAGE(PG8_SA(0, 1), a2 + hstep, voffA);
            PG8_WAIT_V(8); PG8_WAIT_L(0); PG8_BAR; PG8_MMA(0, 0, At, B0); PG8_MMA(0, 1, At, B1); PG8_BAR; PG8_SCHED;
            PG8_LDA(At, 1, 1); PG8_STAGE(PG8_SB(1, 0), b3, voffB); PG8_STAGE(PG8_SB(1, 1), b3 + hstep, voffB); PG8_STAGE(PG8_SA(1, 0), a3, voffA);
            PG8_WAIT_V(8); PG8_WAIT_L(0); PG8_BAR; PG8_MMA(1, 0, At, B0); PG8_MMA(1, 1, At, B1); PG8_BAR; PG8_SCHED;
            } else {
            PG8_LDB(B0, 0, 0); PG8_SCHED; PG8_LDA(At, 0, 0); PG8_STAGE(PG8_SA(1, 1), a1 + hstep, voffA);
            PG8_WAIT_L(8); PG8_BAR; PG8_WAIT_L(0); PG8_MMA(0, 0, At, B0); PG8_BAR; PG8_SCHED;
            PG8_LDB(B1, 0, 1); PG8_STAGE(PG8_SB(0, 0), b2, voffB);
            PG8_BAR; PG8_WAIT_L(0); PG8_MMA(0, 1, At, B1); PG8_BAR;
            PG8_LDA(At, 0, 1); PG8_STAGE(PG8_SA(0, 0), a2, voffA);
            PG8_BAR; PG8_WAIT_L(0); PG8_MMA(1, 0, At, B0); PG8_BAR; PG8_SCHED;
            PG8_STAGE(PG8_SB(0, 1), b2 + hstep, voffB);
            PG8_WAIT_V(6); PG8_BAR; PG8_MMA(1, 1, At, B1); PG8_BAR;
            PG8_LDB(B0, 1, 0); PG8_SCHED; PG8_LDA(At, 1, 0); PG8_STAGE(PG8_SA(0, 1), a2 + hstep, voffA);
            PG8_WAIT_L(8); PG8_BAR; PG8_WAIT_L(0); PG8_MMA(0, 0, At, B0); PG8_BAR; PG8_SCHED;
            PG8_LDB(B1, 1, 1); PG8_STAGE(PG8_SB(1, 0), b3, voffB);
            PG8_BAR; PG8_WAIT_L(0); PG8_MMA(0, 1, At, B1); PG8_BAR;
            PG8_LDA(At, 1, 1); PG8_STAGE(PG8_SA(1, 0), a3, voffA);
            PG8_BAR; PG8_WAIT_L(0); PG8_MMA(1, 0, At, B0); PG8_BAR; PG8_SCHED;
            PG8_STAGE(PG8_SB(1, 1), b3 + hstep, voffB);
            PG8_WAIT_V(6); PG8_BAR; PG8_MMA(1, 1, At, B1); PG8_BAR;
            }
        }
        if constexpr (ALIGN_EPI) { if (wr == 0) PG8_BAR; }
        if constexpr (!Epi::AFTER_DRAIN) { E(acc, cur, wr, wc, fr, fq); S.done(cur); }
        if (!has_next) break;
#pragma unroll
        for (int a = 0; a < 2; ++a)
#pragma unroll
            for (int b = 0; b < 2; ++b)
#pragma unroll
                for (int m = 0; m < 4; ++m)
#pragma unroll
                    for (int n = 0; n < 2; ++n) acc[a][b][m][n] = (f32x4){0.f, 0.f, 0.f, 0.f};
        cur = nxt; cA = nA; cB = nB; ++ui;
        if constexpr (ALIGN_EPI) { if (wr == 1) PG8_BAR; }
    }
    PG8_WAIT_V(0);
    if constexpr (!ALIGN_EPI) { if (wr == 0) PG8_BAR; }
    PG8_BAR;
    if constexpr (Epi::AFTER_DRAIN) { E.fused(acc, cur, wr, wc, fr, fq, lds, wid, lane); S.done(cur); }
#undef PG8_SA
#undef PG8_SB
#undef PG8_STAGE
#undef PG8_LDA
#undef PG8_LDB
#undef PG8_MMA
#undef PG8_WAIT_V
#undef PG8_WAIT_L
#undef PG8_BAR
#undef PG8_SCHED
}
}

#define LAS __attribute__((address_space(3)))
typedef pg8::bf16_t bf16_t;
typedef pg8::bf16x8 bf16x8;
typedef pg8::f32x4 f32x4;
typedef pg8::u32x4 u32x4;
typedef float f32x16 __attribute__((ext_vector_type(16)));
typedef float f32x2 __attribute__((ext_vector_type(2)));
typedef unsigned u32x2 __attribute__((ext_vector_type(2)));

constexpr int NB = 4, SEQ = 8192, DM = 1024, MTOK = NB * SEQ;
constexpr int DFF = 2816;
constexpr int NGRP = 32, NST = 64, GCH = 16, NCHK = SEQ / 64;
constexpr float LOG2E = 1.4426950408889634f;
constexpr float QSCALE = 0.125f * LOG2E;
constexpr float ALPHA = 1.4142135623730951f;
constexpr float LN_EPS = 1e-5f;

constexpr size_t MiB = 1u << 20;
constexpr size_t WS_S5P = 1 * MiB, WS_S5S = 2 * MiB, WS_S5X = 10 * MiB;
constexpr size_t WS_WQKU0 = 18 * MiB, WS_WV0 = 21 * MiB, WS_WGLU = 22 * MiB, WS_WOUT0 = 23 * MiB, WS_W13_0 = 25 * MiB, WS_W2_0 = 36 * MiB;
constexpr size_t WS_WQK1 = 42 * MiB, WS_WV1 = 46 * MiB, WS_WOUT1 = 48 * MiB, WS_W13_1 = 50 * MiB, WS_W2_1 = 61 * MiB;
constexpr size_t WS_HB = 68 * MiB, WS_PROJ = 132 * MiB, WS_VT = 260 * MiB, WS_HID = 132 * MiB, WS_MIX = 324 * MiB, WS_YG = 388 * MiB, WS_END = 420 * MiB;
constexpr size_t S5P_ABAR = 0, S5P_AL = 16384, S5P_BBAR = 65536, S5P_CMAT = 65536 + 262144, S5P_BIAS = S5P_CMAT + 131072;
constexpr int BIAS_LD = 260;

constexpr int LDS_BYTES = 131072 + 1024;

__device__ __forceinline__ float bf2f(unsigned short h) { return __uint_as_float(((unsigned)h) << 16); }
__device__ __forceinline__ unsigned pk2(float lo, float hi) { return pg8::cvt_pk_bf16(lo, hi); }
__device__ __forceinline__ float fast_exp2(float x) { return __builtin_amdgcn_exp2f(x); }
__device__ __forceinline__ float fast_log2(float x) { return __builtin_amdgcn_logf(x); }
__device__ __forceinline__ float fast_rcp(float x) { return __builtin_amdgcn_rcpf(x); }
__device__ __forceinline__ float sigmoidf_(float v) { return fast_rcp(1.0f + fast_exp2(-v * LOG2E)); }

struct EpiStoreBf16 {
    static constexpr bool PERM = true, AFTER_DRAIN = false;
    bf16_t* O; int ldc; int scale_cols; float scale0;
    __device__ __forceinline__ void operator()(const f32x4 (&acc)[2][2][4][2], const pg8::Unit& u, int wr, int wc, int fr, int fq) const {
        const int row0 = u.pm * 256 + wr * 64 + fr, col0 = u.pn * 256 + wc * 32 + 8 * fq;
        const float sc = (u.pn * 256 < scale_cols) ? scale0 : 1.0f;
#pragma unroll
        for (int ai = 0; ai < 2; ++ai)
#pragma unroll
            for (int m = 0; m < 4; ++m) { bf16_t* rowp = O + (size_t)(row0 + ai * 128 + m * 16) * ldc + col0;
#pragma unroll
                for (int bj = 0; bj < 2; ++bj) { const f32x4 v0 = acc[ai][bj][m][0] * sc, v1 = acc[ai][bj][m][1] * sc; u32x4 w;
                    w.x = pk2(v0[0], v0[1]); w.y = pk2(v0[2], v0[3]); w.z = pk2(v1[0], v1[1]); w.w = pk2(v1[2], v1[3]);
                    *(u32x4*)(rowp + bj * 128) = w; } }
    }
};
struct EpiSwiglu {
    static constexpr bool PERM = true, AFTER_DRAIN = false;
    bf16_t* O; int ldc;
    __device__ __forceinline__ void operator()(const f32x4 (&acc)[2][2][4][2], const pg8::Unit& u, int wr, int wc, int fr, int fq) const {
        const int row0 = u.pm * 256 + wr * 64 + fr, col0 = u.pn * 128 + wc * 32 + 8 * fq;
#pragma unroll
        for (int ai = 0; ai < 2; ++ai)
#pragma unroll
            for (int m = 0; m < 4; ++m) { bf16_t* rowp = O + (size_t)(row0 + ai * 128 + m * 16) * ldc + col0; float h[8];
#pragma unroll
                for (int n = 0; n < 2; ++n)
#pragma unroll
                    for (int e = 0; e < 4; ++e) { const float a = acc[ai][0][m][n][e], b = acc[ai][1][m][n][e]; h[n * 4 + e] = a * sigmoidf_(a) * b; }
                u32x4 w; w.x = pk2(h[0], h[1]); w.y = pk2(h[2], h[3]); w.z = pk2(h[4], h[5]); w.w = pk2(h[6], h[7]);
                *(u32x4*)rowp = w; }
    }
};
struct EpiResF32 {
    static constexpr bool PERM = false, AFTER_DRAIN = false;
    const float* res; float* out; float alpha;
    __device__ __forceinline__ void operator()(const f32x4 (&acc)[2][2][4][2], const pg8::Unit& u, int wr, int wc, int fr, int fq) const {
        const int col0 = u.pn * 256 + wc * 32 + 4 * fq;
#pragma unroll
        for (int ai = 0; ai < 2; ++ai)
#pragma unroll
            for (int m = 0; m < 4; ++m) { const size_t off = (size_t)(u.pm * 256 + ai * 128 + wr * 64 + m * 16 + fr) * DM + col0;
#pragma unroll
                for (int bj = 0; bj < 2; ++bj)
#pragma unroll
                    for (int n = 0; n < 2; ++n) { const f32x4 rs = *(const f32x4*)(res + off + bj * 128 + n * 16); *(f32x4*)(out + off + bj * 128 + n * 16) = rs * alpha + acc[ai][bj][m][n]; } }
    }
};
struct EpiGlu {
    static constexpr bool PERM = true, AFTER_DRAIN = false;
    const bf16_t* YG; const float* bias; bf16_t* O;
    __device__ __forceinline__ void operator()(const f32x4 (&acc)[2][2][4][2], const pg8::Unit& u, int wr, int wc, int fr, int fq) const {
        const int row0 = u.pm * 256 + wr * 64 + fr, col0 = u.pn * 256 + wc * 32 + 8 * fq;
#pragma unroll
        for (int ai = 0; ai < 2; ++ai)
#pragma unroll
            for (int m = 0; m < 4; ++m) { const size_t row = (size_t)(row0 + ai * 128 + m * 16);
#pragma unroll
                for (int bj = 0; bj < 2; ++bj) { const int c = col0 + bj * 128;
                    const u32x4 y = *(const u32x4*)(YG + row * 512 + c); const f32x4 b0 = *(const f32x4*)(bias + c), b1 = *(const f32x4*)(bias + c + 4);
                    const f32x4 v0 = acc[ai][bj][m][0] + b0, v1 = acc[ai][bj][m][1] + b1; float o[8];
                    o[0] = bf2f(y.x & 0xffff) * sigmoidf_(v0[0]); o[1] = bf2f(y.x >> 16) * sigmoidf_(v0[1]); o[2] = bf2f(y.y & 0xffff) * sigmoidf_(v0[2]); o[3] = bf2f(y.y >> 16) * sigmoidf_(v0[3]);
                    o[4] = bf2f(y.z & 0xffff) * sigmoidf_(v1[0]); o[5] = bf2f(y.z >> 16) * sigmoidf_(v1[1]); o[6] = bf2f(y.w & 0xffff) * sigmoidf_(v1[2]); o[7] = bf2f(y.w >> 16) * sigmoidf_(v1[3]);
                    u32x4 w; w.x = pk2(o[0], o[1]); w.y = pk2(o[2], o[3]); w.z = pk2(o[4], o[5]); w.w = pk2(o[6], o[7]);
                    *(u32x4*)(O + row * DM + 512 + c) = w; } }
    }
};

__device__ __forceinline__ void transpose_item(const float* W, int ldw, int K, bf16_t* WT, int dst_row0, LAS float* scr, int k0, int n0, int lane) {
#pragma unroll 8
    for (int i = 0; i < 32; ++i) { const int kk = 2 * i + (lane >> 5); scr[kk * 33 + (lane & 31)] = W[(size_t)(k0 + kk) * ldw + n0 + (lane & 31)]; }
    asm volatile("s_waitcnt lgkmcnt(0)" ::: "memory");
    const int c = lane & 7;
#pragma unroll
    for (int j = 0; j < 4; ++j) { const int n = (lane >> 3) + 8 * j; const LAS float* s = scr + (8 * c) * 33 + n;
        u32x4 o; o.x = pk2(s[0 * 33], s[1 * 33]); o.y = pk2(s[2 * 33], s[3 * 33]); o.z = pk2(s[4 * 33], s[5 * 33]); o.w = pk2(s[6 * 33], s[7 * 33]);
        *(u32x4*)(WT + (size_t)(dst_row0 + n) * K + k0 + 8 * c) = o; }
    asm volatile("s_waitcnt lgkmcnt(0)" ::: "memory");
}
__device__ __forceinline__ void transpose_matrix(const float* W, int ldw, int K, int ncols, bf16_t* WT, int row_off, int mode, LAS float* scr, int gw, int ngw, int lane) {
    const int nblk = ncols / 32, nitems = (K / 64) * nblk;
    for (int it = gw; it < nitems; it += ngw) { const int kb = it / nblk, nb = it % nblk, n0 = 32 * nb;
        const int dr = (mode == 0) ? (row_off + n0) : ((n0 >> 7) * 256 + (mode == 2 ? 128 : 0) + (n0 & 127));
        transpose_item(W, ldw, K, WT, dr, scr, 64 * kb, n0, lane); }
}
__device__ __forceinline__ void sincos_f(float x, float& s, float& c) {
    const float k = rintf(x * 0.63661977236758134f);
    float r = fmaf(-k, 1.5707962513e+00f, x); r = fmaf(-k, 7.5497894159e-08f, r); r = fmaf(-k, 5.3903029534e-15f, r);
    const float r2 = r * r;
    const float sp = r + r * r2 * (-1.6666654611e-1f + r2 * (8.3321608736e-3f + r2 * (-1.9515295891e-4f)));
    const float cp = 1.0f - 0.5f * r2 + r2 * r2 * (4.166664568298827e-2f + r2 * (-1.388731625493765e-3f + r2 * 2.443315711809948e-5f));
    const int q = ((int)k) & 3;
    s = (q == 0) ? sp : (q == 1) ? cp : (q == 2) ? -sp : -cp;
    c = (q == 0) ? cp : (q == 1) ? -sp : (q == 2) ? -cp : sp;
}

struct Ctx {
    const float* in[23]; float* out; unsigned char* ws;
    LAS unsigned char* lds;
};
struct Ids { int tid, lane, wave, gw, ngw; };
__device__ __forceinline__ Ids phase_ids() { Ids I; int t = threadIdx.x; asm volatile("" : "+v"(t)); I.tid = t; I.lane = t & 63; I.wave = __builtin_amdgcn_readfirstlane(t >> 6); I.gw = (int)blockIdx.x * 8 + I.wave; I.ngw = (int)gridDim.x * 8; return I; }
template <class T> __device__ __forceinline__ T* wsp(const Ctx& C, size_t off) { return (T*)(C.ws + off); }

__device__ __forceinline__ void phase_prologue(const Ctx& C) {
    const Ids I = phase_ids();
    LAS float* scr = (LAS float*)(C.lds + I.wave * 16384);
    const int gw = I.gw, ngw = I.ngw, lane = I.lane;
    const float* win0 = C.in[1]; const float* win1 = C.in[14];
    transpose_matrix(win0, 2048, 1024, 1024, wsp<bf16_t>(C, WS_WQKU0), 0, 0, scr, gw, ngw, lane);
    transpose_matrix(win0 + 1536, 2048, 1024, 512, wsp<bf16_t>(C, WS_WQKU0), 1024, 0, scr, gw, ngw, lane);
    transpose_matrix(win0 + 1024, 2048, 1024, 512, wsp<bf16_t>(C, WS_WV0), 0, 0, scr, gw, ngw, lane);
    transpose_matrix(C.in[11], 512, 512, 512, wsp<bf16_t>(C, WS_WGLU), 0, 0, scr, gw, ngw, lane);
    transpose_matrix(C.in[13], 1024, 1024, 1024, wsp<bf16_t>(C, WS_WOUT0), 0, 0, scr, gw, ngw, lane);
    transpose_matrix(win1, 3072, 1024, 2048, wsp<bf16_t>(C, WS_WQK1), 0, 0, scr, gw, ngw, lane);
    transpose_matrix(win1 + 2048, 3072, 1024, 1024, wsp<bf16_t>(C, WS_WV1), 0, 0, scr, gw, ngw, lane);
    transpose_matrix(C.in[15], 1024, 1024, 1024, wsp<bf16_t>(C, WS_WOUT1), 0, 0, scr, gw, ngw, lane);
#pragma unroll 1
    for (int l = 0; l < 2; ++l) {
        transpose_matrix(C.in[16] + (size_t)l * DM * DFF, DFF, 1024, DFF, wsp<bf16_t>(C, l ? WS_W13_1 : WS_W13_0), 0, 1, scr, gw, ngw, lane);
        transpose_matrix(C.in[17] + (size_t)l * DM * DFF, DFF, 1024, DFF, wsp<bf16_t>(C, l ? WS_W13_1 : WS_W13_0), 0, 2, scr, gw, ngw, lane);
        transpose_matrix(C.in[18] + (size_t)l * DM * DFF, 1024, DFF, 1024, wsp<bf16_t>(C, l ? WS_W2_1 : WS_W2_0), 0, 0, scr, gw, ngw, lane);
    }
    { const float* x = C.in[0]; bf16_t* xb = wsp<bf16_t>(C, WS_HB); const size_t n8 = (size_t)MTOK * DM / 8, gt = (size_t)blockIdx.x * 512 + I.tid, nt = (size_t)gridDim.x * 512;
      for (size_t i = gt; i < n8; i += nt) { const f32x4 a = *(const f32x4*)(x + i * 8), b = *(const f32x4*)(x + i * 8 + 4); u32x4 w; w.x = pk2(a[0], a[1]); w.y = pk2(a[2], a[3]); w.z = pk2(b[0], b[1]); w.w = pk2(b[2], b[3]); *(u32x4*)(xb + i * 8) = w; } }
    { const int gt = blockIdx.x * 512 + I.tid;
      if (gt < NGRP * NST) { const int g = gt / NST, p = gt % NST;
        const float dt = expf(C.in[10][g]); const float lr = C.in[3][gt], li = C.in[4][gt];
        const float a = lr * dt, b = li * dt; float sb, cb, sh, ch; sincos_f(b, sb, cb); sincos_f(0.5f * b, sh, ch);
        const float mag = expf(a), em1 = expm1f(a);
        const float ar = mag * cb, ai = mag * sb, ar1 = em1 * cb - 2.0f * sh * sh;
        const float den = lr * lr + li * li; const float fr = (ar1 * lr + ai * li) / den, fi = (ai * lr - ar1 * li) / den;
        f32x2* abar = wsp<f32x2>(C, WS_S5P + S5P_ABAR); f32x2* al = wsp<f32x2>(C, WS_S5P + S5P_AL); abar[gt] = (f32x2){ar, ai};
        float pr = ar, pi = ai;
#pragma unroll
        for (int s = 0; s < 6; ++s) { const float nr = pr * pr - pi * pi, ni = 2.0f * pr * pi; pr = nr; pi = ni; }
        al[gt] = (f32x2){pr, pi};
        f32x2* bbar = wsp<f32x2>(C, WS_S5P + S5P_BBAR) + (size_t)gt * GCH; const float* bre = C.in[5] + (size_t)gt * GCH; const float* bim = C.in[6] + (size_t)gt * GCH;
#pragma unroll
        for (int i = 0; i < GCH; ++i) bbar[i] = (f32x2){fr * bre[i] - fi * bim[i], fr * bim[i] + fi * bre[i]};
        bf16_t* cm = wsp<bf16_t>(C, WS_S5P + S5P_CMAT) + (size_t)g * GCH * 128; const float* cre = C.in[7] + (size_t)g * GCH * NST; const float* cim = C.in[8] + (size_t)g * GCH * NST;
#pragma unroll
        for (int i = 0; i < GCH; ++i) { cm[i * 128 + p] = (bf16_t)(pk2(cre[i * NST + p], 0.f) & 0xffff); cm[i * 128 + 64 + p] = (bf16_t)(pk2(-cim[i * NST + p], 0.f) & 0xffff); } }
      if (gt < 8 * 257) { const int h = gt / 257, i = gt % 257; wsp<float>(C, WS_S5P + S5P_BIAS)[h * BIAS_LD + i] = C.in[2][gt] * LOG2E; } }
}

__device__ __forceinline__ void phase_ln(const Ctx& C, float* buf, bf16_t* hb, const float* g, const float* b) {
    const Ids I = phase_ids();
    f32x4 gv[4], bv[4];
#pragma unroll
    for (int j = 0; j < 4; ++j) { gv[j] = *(const f32x4*)(g + 4 * I.lane + 256 * j); bv[j] = *(const f32x4*)(b + 4 * I.lane + 256 * j); }
    for (int m = I.gw; m < MTOK; m += I.ngw) {
        float* row = buf + (size_t)m * DM + 4 * I.lane; f32x4 v[4]; float s = 0.f;
#pragma unroll
        for (int j = 0; j < 4; ++j) { v[j] = *(const f32x4*)(row + 256 * j); s += (v[j][0] + v[j][1]) + (v[j][2] + v[j][3]); }
#pragma unroll
        for (int o = 1; o < 64; o <<= 1) s += __shfl_xor(s, o);
        const float mean = s * (1.0f / DM); float q = 0.f;
#pragma unroll
        for (int j = 0; j < 4; ++j) { v[j] = v[j] - mean; q += (v[j][0] * v[j][0] + v[j][1] * v[j][1]) + (v[j][2] * v[j][2] + v[j][3] * v[j][3]); }
#pragma unroll
        for (int o = 1; o < 64; o <<= 1) q += __shfl_xor(q, o);
        const float rstd = 1.0f / sqrtf(q * (1.0f / DM) + LN_EPS);
        bf16_t* hrow = hb + (size_t)m * DM + 4 * I.lane;
#pragma unroll
        for (int j = 0; j < 4; ++j) { const f32x4 y = v[j] * rstd * gv[j] + bv[j]; *(f32x4*)(row + 256 * j) = y; u32x2 w; w.x = pk2(y[0], y[1]); w.y = pk2(y[2], y[3]); *(u32x2*)(hrow + 256 * j) = w; }
    }
}

constexpr int S5_WAVE_LDS = 4096 + 8704, S5_XLD = 136;
__device__ __forceinline__ void s5_load_u(const Ctx& C, const Ids& I, LAS float* ut, const bf16_t* proj, int b, int g, int c) {
    const bf16_t* up = proj + (size_t)(b * SEQ + c * 64 + I.lane) * 1536 + 1024 + g * GCH;
    const u32x4 a = *(const u32x4*)up, d = *(const u32x4*)(up + 8);
    LAS f32x4* dst = (LAS f32x4*)(ut + I.lane * 16);
    dst[0] = (f32x4){bf2f(a.x & 0xffff), bf2f(a.x >> 16), bf2f(a.y & 0xffff), bf2f(a.y >> 16)}; dst[1] = (f32x4){bf2f(a.z & 0xffff), bf2f(a.z >> 16), bf2f(a.w & 0xffff), bf2f(a.w >> 16)};
    dst[2] = (f32x4){bf2f(d.x & 0xffff), bf2f(d.x >> 16), bf2f(d.y & 0xffff), bf2f(d.y >> 16)}; dst[3] = (f32x4){bf2f(d.z & 0xffff), bf2f(d.z >> 16), bf2f(d.w & 0xffff), bf2f(d.w >> 16)};
    asm volatile("s_waitcnt lgkmcnt(0)" ::: "memory");
}
#define S5_STEP(t) do { const LAS f32x4* ur = (const LAS f32x4*)(ut + (t) * 16); const f32x4 u0 = ur[0], u1 = ur[1], u2 = ur[2], u3 = ur[3]; \
    f32x2 bu = bb[0] * u0[0]; bu += bb[1] * u0[1]; bu += bb[2] * u0[2]; bu += bb[3] * u0[3]; bu += bb[4] * u1[0]; bu += bb[5] * u1[1]; bu += bb[6] * u1[2]; bu += bb[7] * u1[3]; \
    bu += bb[8] * u2[0]; bu += bb[9] * u2[1]; bu += bb[10] * u2[2]; bu += bb[11] * u2[3]; bu += bb[12] * u3[0]; bu += bb[13] * u3[1]; bu += bb[14] * u3[2]; bu += bb[15] * u3[3]; \
    const float nr = A.x * xr - A.y * xi + bu.x, ni = A.x * xi + A.y * xr + bu.y; xr = nr; xi = ni; } while (0)

__device__ __forceinline__ void phase_s5a(const Ctx& C) {
    const Ids I = phase_ids();
    LAS float* ut = (LAS float*)(C.lds + I.wave * S5_WAVE_LDS);
    const bf16_t* proj = wsp<bf16_t>(C, WS_PROJ); f32x2* S = wsp<f32x2>(C, WS_S5S);
    for (int it = I.gw; it < NB * NGRP * NCHK; it += I.ngw) {
        const int c = it % NCHK, g = (it / NCHK) % NGRP, b = it / (NCHK * NGRP);
        const f32x2 A = wsp<f32x2>(C, WS_S5P + S5P_ABAR)[g * NST + I.lane];
        f32x2 bb[16]; { const f32x4* bp = (const f32x4*)(wsp<f32x2>(C, WS_S5P + S5P_BBAR) + (size_t)(g * NST + I.lane) * GCH);
#pragma unroll
            for (int i = 0; i < 8; ++i) { const f32x4 t = bp[i]; bb[2 * i] = (f32x2){t[0], t[1]}; bb[2 * i + 1] = (f32x2){t[2], t[3]}; } }
        s5_load_u(C, I, ut, proj, b, g, c);
        float xr = 0.f, xi = 0.f;
#pragma unroll 4
        for (int t = 0; t < 64; ++t) S5_STEP(t);
        S[(size_t)it * NST + I.lane] = (f32x2){xr, xi};
        asm volatile("s_waitcnt lgkmcnt(0)" ::: "memory");
    }
}
__device__ __forceinline__ void phase_s5b(const Ctx& C) {
    const Ids I = phase_ids();
    const f32x2* S = wsp<f32x2>(C, WS_S5S); f32x2* X = wsp<f32x2>(C, WS_S5X);
    for (int it = I.gw; it < NB * NGRP; it += I.ngw) {
        const int g = it % NGRP; const f32x2 AL = wsp<f32x2>(C, WS_S5P + S5P_AL)[g * NST + I.lane];
        float xr = 0.f, xi = 0.f; const size_t base = (size_t)it * NCHK * NST + I.lane;
#pragma unroll 1
        for (int c0 = 0; c0 < NCHK; c0 += 16) { f32x2 s[16];
#pragma unroll
            for (int j = 0; j < 16; ++j) s[j] = S[base + (size_t)(c0 + j) * NST];
#pragma unroll
            for (int j = 0; j < 16; ++j) { X[base + (size_t)(c0 + j) * NST] = (f32x2){xr, xi}; const float nr = AL.x * xr - AL.y * xi + s[j].x, ni = AL.x * xi + AL.y * xr + s[j].y; xr = nr; xi = ni; } }
    }
}
__device__ __forceinline__ void phase_s5c(const Ctx& C) {
    const Ids I = phase_ids();
    LAS float* ut = (LAS float*)(C.lds + I.wave * S5_WAVE_LDS); LAS bf16_t* xt = (LAS bf16_t*)(C.lds + I.wave * S5_WAVE_LDS + 4096);
    const bf16_t* proj = wsp<bf16_t>(C, WS_PROJ); const f32x2* Xin = wsp<f32x2>(C, WS_S5X); bf16_t* YG = wsp<bf16_t>(C, WS_YG);
    const int l16 = I.lane & 15, kq = I.lane >> 4;
    for (int it = I.gw; it < NB * NGRP * NCHK; it += I.ngw) {
        const int c = it % NCHK, g = (it / NCHK) % NGRP, b = it / (NCHK * NGRP);
        const f32x2 A = wsp<f32x2>(C, WS_S5P + S5P_ABAR)[g * NST + I.lane];
        f32x2 bb[16]; { const f32x4* bp = (const f32x4*)(wsp<f32x2>(C, WS_S5P + S5P_BBAR) + (size_t)(g * NST + I.lane) * GCH);
#pragma unroll
            for (int i = 0; i < 8; ++i) { const f32x4 t = bp[i]; bb[2 * i] = (f32x2){t[0], t[1]}; bb[2 * i + 1] = (f32x2){t[2], t[3]}; } }
        bf16x8 cf[4]; { const bf16_t* cm = wsp<bf16_t>(C, WS_S5P + S5P_CMAT) + (size_t)(g * GCH + l16) * 128 + 8 * kq;
#pragma unroll
            for (int ks = 0; ks < 4; ++ks) cf[ks] = *(const bf16x8*)(cm + ks * 32); }
        const f32x4 dsk = *(const f32x4*)(C.in[9] + g * GCH + 4 * kq);
        s5_load_u(C, I, ut, proj, b, g, c);
        const f32x2 x0 = Xin[(size_t)it * NST + I.lane]; float xr = x0.x, xi = x0.y;
#pragma unroll 1
        for (int half = 0; half < 2; ++half) {
#pragma unroll 4
            for (int tt = 0; tt < 32; ++tt) { S5_STEP(half * 32 + tt);
                const unsigned w = pk2(xr, xi); xt[tt * S5_XLD + I.lane] = (bf16_t)(w & 0xffff); xt[tt * S5_XLD + 64 + I.lane] = (bf16_t)(w >> 16); }
            asm volatile("s_waitcnt lgkmcnt(0)" ::: "memory");
#pragma unroll
            for (int tb = 0; tb < 2; ++tb) { f32x4 acc = {0.f, 0.f, 0.f, 0.f};
#pragma unroll
                for (int ks = 0; ks < 4; ++ks) { const bf16x8 xf = *(const LAS bf16x8*)(xt + (tb * 16 + l16) * S5_XLD + ks * 32 + 8 * kq); acc = __builtin_amdgcn_mfma_f32_16x16x32_bf16(cf[ks], xf, acc, 0, 0, 0); }
                const int t = half * 32 + tb * 16 + l16; const f32x4 uu = *(const LAS f32x4*)(ut + t * 16 + 4 * kq);
                float y[4];
#pragma unroll
                for (int e = 0; e < 4; ++e) { const float v = acc[e] + dsk[e] * uu[e]; const float z = 1.5957691216057308f * (v + 0.044715f * v * v * v); y[e] = v * fast_rcp(1.0f + fast_exp2(-z * LOG2E)); }
                u32x2 w; w.x = pk2(y[0], y[1]); w.y = pk2(y[2], y[3]);
                *(u32x2*)(YG + (size_t)(b * SEQ + c * 64 + t) * 512 + g * GCH + 4 * kq) = w; }
            asm volatile("s_waitcnt lgkmcnt(0)" ::: "memory");
        }
    }
}

__device__ __forceinline__ int crow(int r, int hi) { return (r & 3) + 8 * (r >> 2) + 4 * hi; }
__device__ __forceinline__ f32x16 qk32(const bf16_t* kp, const bf16x8 (&qr)[4]) {
    f32x16 p = {0.f, 0.f, 0.f, 0.f, 0.f, 0.f, 0.f, 0.f, 0.f, 0.f, 0.f, 0.f, 0.f, 0.f, 0.f, 0.f};
#pragma unroll
    for (int d0 = 0; d0 < 4; ++d0) { const bf16x8 kf = *(const bf16x8*)(kp + d0 * 16); p = __builtin_amdgcn_mfma_f32_32x32x16_bf16(kf, qr[d0], p, 0, 0, 0); }
    return p;
}
__device__ __forceinline__ bf16x8 pack8(const f32x16& p, int s) {
    u32x4 w; w.x = pk2(p[8 * s + 0], p[8 * s + 1]); w.y = pk2(p[8 * s + 2], p[8 * s + 3]); w.z = pk2(p[8 * s + 4], p[8 * s + 5]); w.w = pk2(p[8 * s + 6], p[8 * s + 7]);
    return __builtin_bit_cast(bf16x8, w);
}
__device__ __forceinline__ void pv64(f32x16 (&o)[2], const bf16_t* vt, size_t vstride32, const f32x16& p0, const f32x16& p1) {
#pragma unroll
    for (int ks = 0; ks < 4; ++ks) { const bf16x8 pb = (ks < 2) ? pack8(p0, ks & 1) : pack8(p1, ks & 1);
#pragma unroll
        for (int db = 0; db < 2; ++db) { const bf16_t* vp = vt + db * vstride32 + 32 * (ks >> 1) + 16 * (ks & 1);
            const u32x2 lo = *(const u32x2*)vp, hi = *(const u32x2*)(vp + 8); const u32x4 w = {lo.x, lo.y, hi.x, hi.y};
            o[db] = __builtin_amdgcn_mfma_f32_32x32x16_bf16(__builtin_bit_cast(bf16x8, w), pb, o[db], 0, 0, 0); } }
}
__device__ __forceinline__ void store_ot(bf16_t* orow, const f32x16 (&o)[2], float sc, int hi) {
#pragma unroll
    for (int db = 0; db < 2; ++db)
#pragma unroll
        for (int a = 0; a < 4; ++a) { u32x2 w; w.x = pk2(o[db][4 * a] * sc, o[db][4 * a + 1] * sc); w.y = pk2(o[db][4 * a + 2] * sc, o[db][4 * a + 3] * sc); *(u32x2*)(orow + db * 32 + 8 * a + 4 * hi) = w; }
}
__device__ __forceinline__ float half_lo(float v, float& up) { auto rr = __builtin_amdgcn_permlane32_swap(__float_as_uint(v), __float_as_uint(v), false, false); up = __uint_as_float(rr[1]); return __uint_as_float(rr[0]); }

__device__ __forceinline__ void phase_chunk_attn(const Ctx& C) {
    const Ids I = phase_ids();
    const bf16_t* proj = wsp<bf16_t>(C, WS_PROJ); const bf16_t* VT = wsp<bf16_t>(C, WS_VT); bf16_t* MIX = wsp<bf16_t>(C, WS_MIX);
    LAS float* btab = (LAS float*)(C.lds + 122880);
    { const float* src = wsp<float>(C, WS_S5P + S5P_BIAS); for (int i = I.tid; i < 8 * BIAS_LD; i += 512) btab[i] = ((i % BIAS_LD) < 257) ? src[i] : 0.f; }
    __syncthreads();
    const int r32 = I.lane & 31, hi = I.lane >> 5;
    for (int it = I.gw; it < NB * 128 * 8 * 2; it += I.ngw) {
        const int qh = it & 1, h = (it >> 1) & 7, c = (it >> 4) & 127, b = it >> 11;
        const int q0 = c * 64 + qh * 32;
        const size_t rowq = (size_t)b * SEQ + q0 + r32;
        bf16x8 qr[4];
#pragma unroll
        for (int d0 = 0; d0 < 4; ++d0) qr[d0] = *(const bf16x8*)(proj + rowq * 1536 + h * 64 + d0 * 16 + 8 * hi);
        const LAS float* tb = btab + h * BIAS_LD;
        f32x16 o[2]; o[0] = (f32x16){0.f, 0.f, 0.f, 0.f, 0.f, 0.f, 0.f, 0.f, 0.f, 0.f, 0.f, 0.f, 0.f, 0.f, 0.f, 0.f}; o[1] = o[0];
        float m = -1e30f, l = 0.f;
        const int qpos = q0 + r32;
#pragma unroll 1
        for (int kc = (c >= 8 ? c - 8 : 0); kc <= c; ++kc) {
            const int kb = kc * 64;
            const bf16_t* kp = proj + ((size_t)b * SEQ + kb + r32) * 1536 + 512 + h * 64 + 8 * hi;
            f32x16 p0 = qk32(kp, qr), p1 = qk32(kp + (size_t)32 * 1536, qr);
            float mx = -1e30f;
#pragma unroll
            for (int r = 0; r < 16; ++r) { const int d0 = qpos - (kb + crow(r, hi)); const int i0 = min(max(d0, -128), 128) + 128, i1 = min(max(d0 - 32, -128), 128) + 128;
                p0[r] += tb[i0]; p1[r] += tb[i1]; mx = fmaxf(mx, fmaxf(p0[r], p1[r])); }
            { float up; const float lo = half_lo(mx, up); mx = fmaxf(lo, up); }
            const float mn = fmaxf(m, mx), alpha = fast_exp2(m - mn); m = mn;
            float ls = 0.f;
#pragma unroll
            for (int r = 0; r < 16; ++r) { p0[r] = fast_exp2(p0[r] - mn); p1[r] = fast_exp2(p1[r] - mn); ls += p0[r] + p1[r]; }
            l = l * alpha + ls;
#pragma unroll
            for (int r = 0; r < 16; ++r) { o[0][r] *= alpha; o[1][r] *= alpha; }
            pv64(o, VT + (size_t)(h * 64 + r32) * MTOK + (size_t)b * SEQ + kb + 4 * hi, (size_t)32 * MTOK, p0, p1);
        }
        { float up; const float lo = half_lo(l, up); l = lo + up; }
        store_ot(MIX + rowq * DM + h * 64, o, fast_rcp(l), hi);
    }
}

__device__ __forceinline__ void sb_suffix(f32x16& v, float& carry, int hi) {
    float tot[4], oth[4];
#pragma unroll
    for (int a = 0; a < 4; ++a) { const float s3 = v[4 * a + 3], s2 = v[4 * a + 2] + s3, s1 = v[4 * a + 1] + s2, s0 = v[4 * a] + s1; v[4 * a + 3] = s3; v[4 * a + 2] = s2; v[4 * a + 1] = s1; v[4 * a] = s0;
        float up; const float lo = half_lo(s0, up); tot[a] = lo + up; oth[a] = up; }
    float T = carry;
#pragma unroll
    for (int a = 3; a >= 0; --a) { const float base = T + (hi == 0 ? oth[a] : 0.f); v[4 * a] += base; v[4 * a + 1] += base; v[4 * a + 2] += base; v[4 * a + 3] += base; T += tot[a]; }
    carry = T;
}
__device__ __forceinline__ void phase_sb_attn(const Ctx& C) {
    const Ids I = phase_ids();
    const bf16_t* proj = wsp<bf16_t>(C, WS_PROJ); const bf16_t* VT = wsp<bf16_t>(C, WS_VT); bf16_t* MIX = wsp<bf16_t>(C, WS_MIX);
    const int r32 = I.lane & 31, hi = I.lane >> 5;
    for (int it = I.gw; it < NB * 16 * 256; it += I.ngw) {
        const int h = it & 15, qb = 255 - ((it >> 4) & 255), b = it >> 12;
        const int q0 = qb * 32, tq = q0 + r32;
        const size_t rowq = (size_t)b * SEQ + q0 + r32;
        bf16x8 qr[4];
#pragma unroll
        for (int d0 = 0; d0 < 4; ++d0) qr[d0] = *(const bf16x8*)(proj + rowq * 2048 + h * 64 + d0 * 16 + 8 * hi);
        f32x16 o[2]; o[0] = (f32x16){0.f, 0.f, 0.f, 0.f, 0.f, 0.f, 0.f, 0.f, 0.f, 0.f, 0.f, 0.f, 0.f, 0.f, 0.f, 0.f}; o[1] = o[0];
        float carry = 0.f;
#pragma unroll 1
        for (int kb = (q0 >> 6) << 6; kb >= 0; kb -= 64) {
            const bf16_t* kp = proj + ((size_t)b * SEQ + kb + r32) * 2048 + 1024 + h * 64 + 8 * hi;
            f32x16 z0 = qk32(kp, qr), z1 = qk32(kp + (size_t)32 * 2048, qr);
            f32x16 s0, s1;
#pragma unroll
            for (int r = 0; r < 16; ++r) { const int k0 = kb + crow(r, hi);
                const float a0 = z0[r], a1 = z1[r];
                const float sp0 = fmaxf(a0, 0.f) + fast_log2(1.0f + fast_exp2(-fabsf(a0))), sp1 = fmaxf(a1, 0.f) + fast_log2(1.0f + fast_exp2(-fabsf(a1)));
                s0[r] = (k0 < tq) ? sp0 : 0.f; s1[r] = (k0 + 32 < tq) ? sp1 : 0.f; }
            sb_suffix(s1, carry, hi); sb_suffix(s0, carry, hi);
#pragma unroll
            for (int r = 0; r < 16; ++r) { const int k0 = kb + crow(r, hi);
                z0[r] = (k0 < tq) ? fast_exp2(z0[r] - s0[r]) : 0.f; z1[r] = (k0 + 32 < tq) ? fast_exp2(z1[r] - s1[r]) : 0.f; }
            pv64(o, VT + (size_t)(h * 64 + r32) * MTOK + (size_t)b * SEQ + kb + 4 * hi, (size_t)32 * MTOK, z0, z1);
            if (__all(carry >= 150.0f)) break;
        }
        store_ot(MIX + rowq * DM + h * 64, o, 1.0f, hi);
    }
}

struct Params { const float* in[23]; float* out; unsigned char* ws; };
#define GSYNC() do { __threadfence(); grid.sync(); } while (0)
template <int K, class Epi> __device__ __forceinline__ void run_gemm(const Ctx& C, const bf16_t* A, const bf16_t* Bt, int M, int N, const Epi& E) {
    pg8::Gemm g{A, Bt, M, N, K}; pg8::StaticOrder S; S.init(M, N, (int)gridDim.x, (int)blockIdx.x);
    pg8::gemm_phase<Epi, pg8::StaticOrder, true, true, K>(C.lds, g, S, E);
}
__global__ void __launch_bounds__(512, 2) fwd_megakernel(Params P) {
    extern __shared__ __attribute__((aligned(16))) unsigned char lds_raw[];
    cg::grid_group grid = cg::this_grid();
    Ctx C;
#pragma unroll
    for (int i = 0; i < 23; ++i) C.in[i] = P.in[i];
    C.out = P.out; C.ws = P.ws; C.lds = (LAS unsigned char*)lds_raw;
    bf16_t* HB = wsp<bf16_t>(C, WS_HB); bf16_t* PROJ = wsp<bf16_t>(C, WS_PROJ); bf16_t* VT = wsp<bf16_t>(C, WS_VT); bf16_t* MIX = wsp<bf16_t>(C, WS_MIX); bf16_t* HID = wsp<bf16_t>(C, WS_HID);

    phase_prologue(C);
    GSYNC();
#pragma unroll
    for (int layer = 0; layer < 2; ++layer) {
        { const int nqk = layer ? 2048 : 1536, nv = layer ? 1024 : 512;
          EpiStoreBf16 E1{PROJ, nqk, layer ? 1024 : 512, QSCALE};
          run_gemm<1024>(C, HB, wsp<bf16_t>(C, layer ? WS_WQK1 : WS_WQKU0), MTOK, nqk, E1);
          EpiStoreBf16 E2{VT, MTOK, 0, 1.0f};
          run_gemm<1024>(C, wsp<bf16_t>(C, layer ? WS_WV1 : WS_WV0), HB, nv, MTOK, E2); }
        GSYNC();
        if (layer == 0) {
            phase_s5a(C);
            GSYNC();
            phase_s5b(C);
            phase_chunk_attn(C);
            GSYNC();
            phase_s5c(C);
            GSYNC();
            { EpiGlu E{wsp<bf16_t>(C, WS_YG), C.in[12], MIX}; run_gemm<512>(C, wsp<bf16_t>(C, WS_YG), wsp<bf16_t>(C, WS_WGLU), MTOK, 512, E); }
        } else {
            phase_sb_attn(C);
        }
        GSYNC();
        { EpiResF32 E{layer ? C.out : C.in[0], C.out, ALPHA}; run_gemm<1024>(C, MIX, wsp<bf16_t>(C, layer ? WS_WOUT1 : WS_WOUT0), MTOK, DM, E); }
        GSYNC();
        phase_ln(C, C.out, HB, C.in[19] + layer * DM, C.in[20] + layer * DM);
        GSYNC();
        { EpiSwiglu E{HID, DFF}; run_gemm<1024>(C, HB, wsp<bf16_t>(C, layer ? WS_W13_1 : WS_W13_0), MTOK, 2 * DFF, E); }
        GSYNC();
        { EpiResF32 E{C.out, C.out, ALPHA}; run_gemm<2816>(C, HID, wsp<bf16_t>(C, layer ? WS_W2_1 : WS_W2_0), MTOK, DM, E); }
        GSYNC();
        phase_ln(C, C.out, HB, C.in[21] + layer * DM, C.in[22] + layer * DM);
        if (layer == 0) GSYNC();
    }
}

extern "C" void kernel_launch(void* const* d_in, const int* in_sizes, int n_in, void* d_out, int out_size, void* d_ws, size_t ws_size, hipStream_t stream) {
    static int grid = 0;
    if (grid == 0) {
        if (n_in != 23 || out_size != MTOK * DM || ws_size < WS_END) { fprintf(stderr, "kernel_launch: unexpected shapes (n_in %d, out %d, ws %zu)\n", n_in, out_size, ws_size); grid = -1; return; }
        int dev = 0, cus = 0, per_cu = 0;
        hipGetDevice(&dev); hipDeviceGetAttribute(&cus, hipDeviceAttributeMultiprocessorCount, dev);
        hipFuncSetAttribute((const void*)fwd_megakernel, hipFuncAttributeMaxDynamicSharedMemorySize, LDS_BYTES);
        hipOccupancyMaxActiveBlocksPerMultiprocessor(&per_cu, (const void*)fwd_megakernel, 512, LDS_BYTES);
        if (per_cu < 1) { fprintf(stderr, "kernel_launch: occupancy query says %d blocks per CU\n", per_cu); per_cu = 1; }
        grid = cus * 1;
        (void)hipGetLastError();
    }
    if (grid < 0) return;
    Params p{};
    for (int i = 0; i < 23; ++i) p.in[i] = (const float*)d_in[i];
    p.out = (float*)d_out; p.ws = (unsigned char*)d_ws;
    void* args[] = {&p};
    hipError_t e = hipLaunchCooperativeKernel((const void*)fwd_megakernel, dim3(grid), dim3(512), args, LDS_BYTES, stream);
    if (e != hipSuccess) fprintf(stderr, "cooperative launch failed: %s (grid %d)\n", hipGetErrorString(e), grid);
}
```

```cpp
#include <hip/hip_runtime.h>
#include <hip/hip_cooperative_groups.h>
#include <cstdio>
#include <cstdint>
namespace cg = cooperative_groups;
#ifndef REP_PRO
#define REP_PRO 1
#define REP_S5 1
#define REP_CA 1
#define REP_SB 1
#define REP_SYNC 1
#endif
namespace pg8 {
#define PG8_LAS __attribute__((address_space(3)))
typedef unsigned short bf16_t;
typedef short bf16x8 __attribute__((ext_vector_type(8)));
typedef float f32x4 __attribute__((ext_vector_type(4)));
typedef unsigned u32x4 __attribute__((ext_vector_type(4)));
constexpr int BM = 256, BK = 64, HALF = 128, HTB = HALF * BK * 2  , STAGE_BYTES = 8 * HTB, NXCD = 8, WGM = 8;

__host__ __device__ __forceinline__ int lds_byte(int r, int c) { const int st = (r >> 4) * 2 + (c >> 5), rr = r & 15, cc = c & 31, ob = rr * 64 + cc * 2; return st * 1024 + (ob ^ (((ob >> 9) & 1) << 5)); }
__host__ __device__ __forceinline__ void stage_rc(int b, int& R, int& C) { const int st = b / 1024, sb = b % 1024, swz = sb ^ (((sb >> 9) & 1) << 5); R = (st >> 1) * 16 + swz / 64; C = (st & 1) * 32 + (swz % 64) / 2; }
__host__ __device__ __forceinline__ int perm32(int rho) { const int n = rho >> 4, i = rho & 15; return 8 * (i >> 2) + 4 * n + (i & 3); }

struct Unit { int pm, pn; };
struct Gemm { const bf16_t* A; const bf16_t* Bt; int M, N, K; };

struct StaticOrder {
    int nM, nN, nwg, G, c;
    __host__ __device__ void init(int M, int N, int G_, int c_) { nM = M / BM; nN = N / BM; nwg = nM * nN; G = G_; c = c_; }
    __host__ __device__ bool next(int i, Unit& u) const {
        const long L = (long)i * G + c; if (L >= nwg) return false;
        int wgid = (int)L; { const int q = nwg / NXCD, r = nwg % NXCD, xcd = wgid % NXCD, off = wgid / NXCD; wgid = (xcd < r ? xcd * (q + 1) : r * (q + 1) + (xcd - r) * q) + off; }
        const int nig = WGM * nN, gid = wgid / nig, fm = gid * WGM, gsz = (nM - fm) < WGM ? (nM - fm) : WGM;
        u.pm = fm + ((wgid % nig) % gsz); u.pn = (wgid % nig) / gsz; return true;
    }
    __device__ __forceinline__ void a_ready(const Unit&) const {}
    __device__ __forceinline__ void done(const Unit&) const {}
};

__device__ __forceinline__ unsigned cvt_pk_bf16(float lo, float hi) { unsigned r; asm volatile("v_cvt_pk_bf16_f32 %0, %1, %2" : "=v"(r) : "v"(lo), "v"(hi)); return r; }
typedef float f32x2 __attribute__((ext_vector_type(2)));
template <class Epi, class Sched, bool ALIGN_EPI, bool SP2, int KC>
__device__ __forceinline__ void gemm_phase(PG8_LAS unsigned char* lds, const Gemm g, const Sched& S, const Epi& E) {
    int tid_ = threadIdx.x; asm volatile("" : "+v"(tid_)); const int tid = tid_, wid = __builtin_amdgcn_readfirstlane(tid >> 6), lane = tid & 63, wr = wid >> 2, wc = wid & 3, fr = lane & 15, fq = lane >> 4;
    constexpr int K = KC, nt = K / BK;
    unsigned voffA[2], voffB[2];
#pragma unroll
    for (int i = 0; i < 2; ++i) { int R, C; stage_rc(tid * 16 + i * 8192, R, C); const int Rb = Epi::PERM ? ((R & ~31) + perm32(R & 31)) : R;
        voffA[i] = (unsigned)(R * K + C) * 2u; voffB[i] = (unsigned)(Rb * K + C) * 2u; }
    const size_t kstep = (size_t)(BK * 2);
    const size_t hstep = (size_t)HALF * K * 2;
    const size_t tstep = 2 * hstep;
    const unsigned ldsw = (unsigned)wid * 1024u;
    const int aoff = lds_byte(wr * 64 + fr, fq * 8), boff = lds_byte(wc * 32 + fr, fq * 8);
#define PG8_SA(b, h) (((b) * 2 + (h)) * HTB)
#define PG8_SB(b, h) ((4 + (b) * 2 + (h)) * HTB)
#define PG8_STAGE(bufoff, gbase, voff) do { _Pragma("unroll") for (int _i = 0; _i < 2; ++_i) \
        __builtin_amdgcn_global_load_lds((const unsigned*)((const char*)(gbase) + (voff)[_i]), (PG8_LAS unsigned*)(lds + (bufoff) + ldsw + _i * 8192), 16, 0, 0); } while (0)
#define PG8_LDA(dst, b, h) do { _Pragma("unroll") for (int m = 0; m < 4; ++m) _Pragma("unroll") for (int k = 0; k < 2; ++k) dst[m][k] = *(const PG8_LAS bf16x8*)(lds + PG8_SA(b, h) + aoff + m * 2048 + k * 1024); } while (0)
#define PG8_LDB(dst, b, h) do { _Pragma("unroll") for (int n = 0; n < 2; ++n) _Pragma("unroll") for (int k = 0; k < 2; ++k) dst[n][k] = *(const PG8_LAS bf16x8*)(lds + PG8_SB(b, h) + boff + n * 2048 + k * 1024); } while (0)
#define PG8_MMA(ai, bj, At, Bt) do { __builtin_amdgcn_s_setprio(1); _Pragma("unroll") for (int m = 0; m < 4; ++m) _Pragma("unroll") for (int n = 0; n < 2; ++n) _Pragma("unroll") for (int k = 0; k < 2; ++k) \
        acc[ai][bj][m][n] = __builtin_amdgcn_mfma_f32_16x16x32_bf16(Bt[n][k], At[m][k], acc[ai][bj][m][n], 0, 0, 0); __builtin_amdgcn_s_setprio(0); } while (0)
#define PG8_WAIT_V(n) asm volatile("s_waitcnt vmcnt(" #n ")" ::: "memory")
#define PG8_WAIT_L(n) asm volatile("s_waitcnt lgkmcnt(" #n ")" ::: "memory")
#define PG8_BAR __builtin_amdgcn_s_barrier()
#define PG8_SCHED __builtin_amdgcn_sched_barrier(0)
    Unit cur, nxt; int ui = 0;
    if (!S.next(0, cur)) return;
    f32x4 acc[2][2][4][2];
#pragma unroll
    for (int a = 0; a < 2; ++a)
#pragma unroll
        for (int b = 0; b < 2; ++b)
#pragma unroll
            for (int m = 0; m < 4; ++m)
#pragma unroll
                for (int n = 0; n < 2; ++n) acc[a][b][m][n] = (f32x4){0.f, 0.f, 0.f, 0.f};
    bf16x8 At[4][2], B0[2][2], B1[2][2];
    const char* cA = (const char*)g.A + (size_t)cur.pm * tstep; const char* cB = (const char*)g.Bt + (size_t)cur.pn * tstep;
    S.a_ready(cur);
    if constexpr (SP2) {
        PG8_STAGE(PG8_SB(0, 0), cB, voffB); PG8_STAGE(PG8_SB(0, 1), cB + hstep, voffB); PG8_STAGE(PG8_SA(0, 0), cA, voffA); PG8_STAGE(PG8_SA(0, 1), cA + hstep, voffA);
        if (wr == 1) PG8_BAR;
        PG8_WAIT_V(2); PG8_BAR;
        PG8_STAGE(PG8_SB(1, 0), cB + kstep, voffB); PG8_STAGE(PG8_SA(1, 0), cA + kstep, voffA); PG8_STAGE(PG8_SB(1, 1), cB + hstep + kstep, voffB);
        PG8_WAIT_V(6); PG8_BAR;
    } else {
        PG8_STAGE(PG8_SB(0, 0), cB, voffB); PG8_STAGE(PG8_SA(0, 0), cA, voffA); PG8_STAGE(PG8_SB(0, 1), cB + hstep, voffB); PG8_STAGE(PG8_SA(0, 1), cA + hstep, voffA);
        if (wr == 1) PG8_BAR;
        PG8_WAIT_V(4); PG8_BAR;
        PG8_STAGE(PG8_SB(1, 0), cB + kstep, voffB); PG8_STAGE(PG8_SA(1, 0), cA + kstep, voffA); PG8_STAGE(PG8_SB(1, 1), cB + hstep + kstep, voffB);
        PG8_WAIT_V(6); PG8_BAR;
    }
    for (;;) {
        const bool has_next = S.next(ui + 1, nxt);
        const char* nA = has_next ? (const char*)g.A + (size_t)nxt.pm * tstep : cA; const char* nB = has_next ? (const char*)g.Bt + (size_t)nxt.pn * tstep : cB;
        for (int t = 0; t < nt; t += 2) {
            const bool last = (t == nt - 2);
            const char* a1 = cA + (size_t)(t + 1) * kstep;
            const char* a2 = last ? nA : cA + (size_t)(t + 2) * kstep; const char* b2 = last ? nB : cB + (size_t)(t + 2) * kstep;
            const char* a3 = a2 + kstep; const char* b3 = b2 + kstep;
            if (last && has_next) S.a_ready(nxt);
            if constexpr (SP2) {
            PG8_LDB(B0, 0, 0); PG8_LDB(B1, 0, 1); PG8_SCHED; PG8_LDA(At, 0, 0); PG8_STAGE(PG8_SA(1, 1), a1 + hstep, voffA);
            PG8_WAIT_V(8); PG8_WAIT_L(0); PG8_BAR; PG8_MMA(0, 0, At, B0); PG8_MMA(0, 1, At, B1); PG8_BAR; PG8_SCHED;
            PG8_LDA(At, 0, 1); PG8_STAGE(PG8_SB(0, 0), b2, voffB); PG8_STAGE(PG8_SB(0, 1), b2 + hstep, voffB); PG8_STAGE(PG8_SA(0, 0), a2, voffA);
            PG8_WAIT_V(8); PG8_WAIT_L(0); PG8_BAR; PG8_MMA(1, 0, At, B0); PG8_MMA(1, 1, At, B1); PG8_BAR; PG8_SCHED;
            PG8_LDB(B0, 1, 0); PG8_LDB(B1, 1, 1); PG8_SCHED; PG8_LDA(At, 1, 0); PG8_STAGE(PG8_SA(0, 1), a2 + hstep, voffA);
            PG8_WAIT_V(8); PG8_WAIT_L(0); PG8_BAR; PG8_MMA(0, 0, At, B0); PG8_MMA(0, 1, At, B1); PG8_BAR; PG8_SCHED;
            PG8_LDA(At, 1, 1); PG8_STAGE(PG8_SB(1, 0), b3, voffB); PG8_STAGE(PG8_SB(1, 1), b3 + hstep, voffB); PG8_STAGE(PG8_SA(1, 0), a3, voffA);
            PG8_WAIT_V(8); PG8_WAIT_L(0); PG8_BAR; PG8_MMA(1, 0, At, B0); PG8_MMA(1, 1, At, B1); PG8_BAR; PG8_SCHED;
            } else {
            PG8_LDB(B0, 0, 0); PG8_SCHED; PG8_LDA(At, 0, 0); PG8_STAGE(PG8_SA(1, 1), a1 + hstep, voffA);
            PG8_WAIT_L(8); PG8_BAR; PG8_WAIT_L(0); PG8_MMA(0, 0, At, B0); PG8_BAR; PG8_SCHED;
            PG8_LDB(B1, 0, 1); PG8_STAGE(PG8_SB(0, 0), b2, voffB);
            PG8_BAR; PG8_WAIT_L(0); PG8_MMA(0, 1, At, B1); PG8_BAR;
            PG8_LDA(At, 0, 1); PG8_STAGE(PG8_SA(0, 0), a2, voffA);
            PG8_BAR; PG8_WAIT_L(0); PG8_MMA(1, 0, At, B0); PG8_BAR; PG8_SCHED;
            PG8_STAGE(PG8_SB(0, 1), b2 + hstep, voffB);
            PG8_WAIT_V(6); PG8_BAR; PG8_MMA(1, 1, At, B1); PG8_BAR;
            PG8_LDB(B0, 1, 0); PG8_SCHED; PG8_LDA(At, 1, 0); PG8_STAGE(PG8_SA(0, 1), a2 + hstep, voffA);
            PG8_WAIT_L(8); PG8_BAR; PG8_WAIT_L(0); PG8_MMA(0, 0, At, B0); PG8_BAR; PG8_SCHED;
            PG8_LDB(B1, 1, 1); PG8_STAGE(PG8_SB(1, 0), b3, voffB);
            PG8_BAR; PG8_WAIT_L(0); PG8_MMA(0, 1, At, B1); PG8_BAR;
            PG8_LDA(At, 1, 1); PG8_STAGE(PG8_SA(1, 0), a3, voffA);
            PG8_BAR; PG8_WAIT_L(0); PG8_MMA(1, 0, At, B0); PG8_BAR; PG8_SCHED;
            PG8_STAGE(PG8_SB(1, 1), b3 + hstep, voffB);
            PG8_WAIT_V(6); PG8_BAR; PG8_MMA(1, 1, At, B1); PG8_BAR;
            }
        }
        if constexpr (ALIGN_EPI) { if (wr == 0) PG8_BAR; }
        if constexpr (!Epi::AFTER_DRAIN) { E(acc, cur, wr, wc, fr, fq); S.done(cur); }
        if (!has_next) break;
#pragma unroll
        for (int a = 0; a < 2; ++a)
#pragma unroll
            for (int b = 0; b < 2; ++b)
#pragma unroll
                for (int m = 0; m < 4; ++m)
#pragma unroll
                    for (int n = 0; n < 2; ++n) acc[a][b][m][n] = (f32x4){0.f, 0.f, 0.f, 0.f};
        cur = nxt; cA = nA; cB = nB; ++ui;
        if constexpr (ALIGN_EPI) { if (wr == 1) PG8_BAR; }
    }
    PG8_WAIT_V(0);
    if constexpr (!ALIGN_EPI) { if (wr == 0) PG8_BAR; }
    PG8_BAR;
    if constexpr (Epi::AFTER_DRAIN) { E.fused(acc, cur, wr, wc, fr, fq, lds, wid, lane); S.done(cur); }
#undef PG8_SA
#undef PG8_SB
#undef PG8_STAGE
#undef PG8_LDA
#undef PG8_LDB
#undef PG8_MMA
#undef PG8_WAIT_V
#undef PG8_WAIT_L
#undef PG8_BAR
#undef PG8_SCHED
}
}

#define LAS __attribute__((address_space(3)))
typedef pg8::bf16_t bf16_t;
typedef pg8::bf16x8 bf16x8;
typedef pg8::f32x4 f32x4;
typedef pg8::u32x4 u32x4;
typedef float f32x16 __attribute__((ext_vector_type(16)));
typedef float f32x2 __attribute__((ext_vector_type(2)));
typedef unsigned u32x2 __attribute__((ext_vector_type(2)));

constexpr int NB = 4, SEQ = 8192, DM = 1024, MTOK = NB * SEQ;
constexpr int DFF = 2816;
constexpr int NGRP = 32, NST = 64, GCH = 16, NCHK = SEQ / 64;
constexpr float LOG2E = 1.4426950408889634f;
constexpr float QSCALE = 0.125f * LOG2E;
constexpr float ALPHA = 1.4142135623730951f;
constexpr float LN_EPS = 1e-5f;

constexpr size_t MiB = 1u << 20;
constexpr size_t WS_S5P = 1 * MiB, WS_S5S = 2 * MiB, WS_S5X = 10 * MiB;
constexpr size_t WS_WQKU0 = 18 * MiB, WS_WV0 = 21 * MiB, WS_WGLU = 22 * MiB, WS_WOUT0 = 23 * MiB, WS_W13_0 = 25 * MiB, WS_W2_0 = 36 * MiB;
constexpr size_t WS_WQK1 = 42 * MiB, WS_WV1 = 46 * MiB, WS_WOUT1 = 48 * MiB, WS_W13_1 = 50 * MiB, WS_W2_1 = 61 * MiB;
constexpr size_t WS_HB = 68 * MiB, WS_PROJ = 132 * MiB, WS_VT = 260 * MiB, WS_HID = 132 * MiB, WS_MIX = 324 * MiB, WS_YG = 388 * MiB, WS_END = 420 * MiB;
constexpr size_t S5P_ABAR = 0, S5P_AL = 16384, S5P_BBAR = 65536, S5P_CMAT = 65536 + 262144, S5P_BIAS = S5P_CMAT + 131072;
constexpr int BIAS_LD = 260;

constexpr int LDS_BYTES = 131072 + 1024;

__device__ __forceinline__ float bf2f(unsigned short h) { return __uint_as_float(((unsigned)h) << 16); }
__device__ __forceinline__ unsigned pk2(float lo, float hi) { return pg8::cvt_pk_bf16(lo, hi); }
__device__ __forceinline__ float fast_exp2(float x) { return __builtin_amdgcn_exp2f(x); }
__device__ __forceinline__ float fast_log2(float x) { return __builtin_amdgcn_logf(x); }
__device__ __forceinline__ float fast_rcp(float x) { return __builtin_amdgcn_rcpf(x); }
__device__ __forceinline__ float sigmoidf_(float v) { return fast_rcp(1.0f + fast_exp2(-v * LOG2E)); }

struct EpiStoreBf16 {
    static constexpr bool PERM = true, AFTER_DRAIN = false;
    bf16_t* O; int ldc; int scale_cols; float scale0;
    __device__ __forceinline__ void operator()(const f32x4 (&acc)[2][2][4][2], const pg8::Unit& u, int wr, int wc, int fr, int fq) const {
        const int row0 = u.pm * 256 + wr * 64 + fr, col0 = u.pn * 256 + wc * 32 + 8 * fq;
        const float sc = (u.pn * 256 < scale_cols) ? scale0 : 1.0f;
#pragma unroll
        for (int ai = 0; ai < 2; ++ai)
#pragma unroll
            for (int m = 0; m < 4; ++m) { bf16_t* rowp = O + (size_t)(row0 + ai * 128 + m * 16) * ldc + col0;
#pragma unroll
                for (int bj = 0; bj < 2; ++bj) { const f32x4 v0 = acc[ai][bj][m][0] * sc, v1 = acc[ai][bj][m][1] * sc; u32x4 w;
                    w.x = pk2(v0[0], v0[1]); w.y = pk2(v0[2], v0[3]); w.z = pk2(v1[0], v1[1]); w.w = pk2(v1[2], v1[3]);
                    *(u32x4*)(rowp + bj * 128) = w; } }
    }
};
struct EpiSwiglu {
    static constexpr bool PERM = true, AFTER_DRAIN = false;
    bf16_t* O; int ldc;
    __device__ __forceinline__ void operator()(const f32x4 (&acc)[2][2][4][2], const pg8::Unit& u, int wr, int wc, int fr, int fq) const {
        const int row0 = u.pm * 256 + wr * 64 + fr, col0 = u.pn * 128 + wc * 32 + 8 * fq;
#pragma unroll
        for (int ai = 0; ai < 2; ++ai)
#pragma unroll
            for (int m = 0; m < 4; ++m) { bf16_t* rowp = O + (size_t)(row0 + ai * 128 + m * 16) * ldc + col0; float h[8];
#pragma unroll
                for (int n = 0; n < 2; ++n)
#pragma unroll
                    for (int e = 0; e < 4; ++e) { const float a = acc[ai][0][m][n][e], b = acc[ai][1][m][n][e]; h[n * 4 + e] = a * sigmoidf_(a) * b; }
                u32x4 w; w.x = pk2(h[0], h[1]); w.y = pk2(h[2], h[3]); w.z = pk2(h[4], h[5]); w.w = pk2(h[6], h[7]);
                *(u32x4*)rowp = w; }
    }
};
struct EpiResF32 {
    static constexpr bool PERM = false, AFTER_DRAIN = false;
    const float* res; float* out; float alpha;
    __device__ __forceinline__ void operator()(const f32x4 (&acc)[2][2][4][2], const pg8::Unit& u, int wr, int wc, int fr, int fq) const {
        const int col0 = u.pn * 256 + wc * 32 + 4 * fq;
#pragma unroll
        for (int ai = 0; ai < 2; ++ai)
#pragma unroll
            for (int m = 0; m < 4; ++m) { const size_t off = (size_t)(u.pm * 256 + ai * 128 + wr * 64 + m * 16 + fr) * DM + col0;
#pragma unroll
                for (int bj = 0; bj < 2; ++bj)
#pragma unroll
                    for (int n = 0; n < 2; ++n) { const f32x4 rs = *(const f32x4*)(res + off + bj * 128 + n * 16); *(f32x4*)(out + off + bj * 128 + n * 16) = rs * alpha + acc[ai][bj][m][n]; } }
    }
};
struct EpiGlu {
    static constexpr bool PERM = true, AFTER_DRAIN = false;
    const bf16_t* YG; const float* bias; bf16_t* O;
    __device__ __forceinline__ void operator()(const f32x4 (&acc)[2][2][4][2], const pg8::Unit& u, int wr, int wc, int fr, int fq) const {
        const int row0 = u.pm * 256 + wr * 64 + fr, col0 = u.pn * 256 + wc * 32 + 8 * fq;
#pragma unroll
        for (int ai = 0; ai < 2; ++ai)
#pragma unroll
            for (int m = 0; m < 4; ++m) { const size_t row = (size_t)(row0 + ai * 128 + m * 16);
#pragma unroll
                for (int bj = 0; bj < 2; ++bj) { const int c = col0 + bj * 128;
                    const u32x4 y = *(const u32x4*)(YG + row * 512 + c); const f32x4 b0 = *(const f32x4*)(bias + c), b1 = *(const f32x4*)(bias + c + 4);
                    const f32x4 v0 = acc[ai][bj][m][0] + b0, v1 = acc[ai][bj][m][1] + b1; float o[8];
                    o[0] = bf2f(y.x & 0xffff) * sigmoidf_(v0[0]); o[1] = bf2f(y.x >> 16) * sigmoidf_(v0[1]); o[2] = bf2f(y.y & 0xffff) * sigmoidf_(v0[2]); o[3] = bf2f(y.y >> 16) * sigmoidf_(v0[3]);
                    o[4] = bf2f(y.z & 0xffff) * sigmoidf_(v1[0]); o[5] = bf2f(y.z >> 16) * sigmoidf_(v1[1]); o[6] = bf2f(y.w & 0xffff) * sigmoidf_(v1[2]); o[7] = bf2f(y.w >> 16) * sigmoidf_(v1[3]);
                    u32x4 w; w.x = pk2(o[0], o[1]); w.y = pk2(o[2], o[3]); w.z = pk2(o[4], o[5]); w.w = pk2(o[6], o[7]);
                    *(u32x4*)(O + row * DM + 512 + c) = w; } }
    }
};

__device__ __forceinline__ void transpose_item(const float* W, int ldw, int K, bf16_t* WT, int dst_row0, LAS float* scr, int k0, int n0, int lane) {
#pragma unroll 8
    for (int i = 0; i < 32; ++i) { const int kk = 2 * i + (lane >> 5); scr[kk * 33 + (lane & 31)] = W[(size_t)(k0 + kk) * ldw + n0 + (lane & 31)]; }
    asm volatile("s_waitcnt lgkmcnt(0)" ::: "memory");
    const int c = lane & 7;
#pragma unroll
    for (int j = 0; j < 4; ++j) { const int n = (lane >> 3) + 8 * j; const LAS float* s = scr + (8 * c) * 33 + n;
        u32x4 o; o.x = pk2(s[0 * 33], s[1 * 33]); o.y = pk2(s[2 * 33], s[3 * 33]); o.z = pk2(s[4 * 33], s[5 * 33]); o.w = pk2(s[6 * 33], s[7 * 33]);
        *(u32x4*)(WT + (size_t)(dst_row0 + n) * K + k0 + 8 * c) = o; }
    asm volatile("s_waitcnt lgkmcnt(0)" ::: "memory");
}
__device__ __forceinline__ void transpose_matrix(const float* W, int ldw, int K, int ncols, bf16_t* WT, int row_off, int mode, LAS float* scr, int gw, int ngw, int lane) {
    const int nblk = ncols / 32, nitems = (K / 64) * nblk;
    for (int it = gw; it < nitems; it += ngw) { const int kb = it / nblk, nb = it % nblk, n0 = 32 * nb;
        const int dr = (mode == 0) ? (row_off + n0) : ((n0 >> 7) * 256 + (mode == 2 ? 128 : 0) + (n0 & 127));
        transpose_item(W, ldw, K, WT, dr, scr, 64 * kb, n0, lane); }
}
__device__ __forceinline__ void sincos_f(float x, float& s, float& c) {
    const float k = rintf(x * 0.63661977236758134f);
    float r = fmaf(-k, 1.5707962513e+00f, x); r = fmaf(-k, 7.5497894159e-08f, r); r = fmaf(-k, 5.3903029534e-15f, r);
    const float r2 = r * r;
    const float sp = r + r * r2 * (-1.6666654611e-1f + r2 * (8.3321608736e-3f + r2 * (-1.9515295891e-4f)));
    const float cp = 1.0f - 0.5f * r2 + r2 * r2 * (4.166664568298827e-2f + r2 * (-1.388731625493765e-3f + r2 * 2.443315711809948e-5f));
    const int q = ((int)k) & 3;
    s = (q == 0) ? sp : (q == 1) ? cp : (q == 2) ? -sp : -cp;
    c = (q == 0) ? cp : (q == 1) ? -sp : (q == 2) ? -cp : sp;
}

#define XB_TMO      128
#define XB_XCNT(j)  (256  + 64 * (j))
#define XB_XSUB(j)  (1280 + 64 * (j))
#define XB_XGEN(j)  (2304 + 64 * (j))
#define XB_TOP      3328
#define XB_TOPGEN   3392
#define XCD_BAR_WORDS 3456
#define XB_SPIN_CAP (1u << 18)

__device__ __forceinline__ unsigned xb_ld(unsigned* p)              { return __hip_atomic_load(p, __ATOMIC_RELAXED, __HIP_MEMORY_SCOPE_AGENT); }
__device__ __forceinline__ unsigned xb_add(unsigned* p, unsigned v) { return __hip_atomic_fetch_add(p, v, __ATOMIC_RELAXED, __HIP_MEMORY_SCOPE_AGENT); }
__device__ __forceinline__ unsigned xb_xcc_id() { return (unsigned)__builtin_amdgcn_s_getreg((3 << 11) | 20) & 0xFu; }
#define XB_SPIN(cond, bar) do { unsigned _sp = 0; while (cond) { __builtin_amdgcn_s_sleep(1); \
    if ((++_sp & 255u) == 0u) { if (xb_ld(&(bar)[XB_TMO])) break; if (_sp > XB_SPIN_CAP) { atomicAdd(&(bar)[XB_TMO], 1u); break; } } } } while (0)

struct XcdBarrier {
    unsigned* bar; unsigned x;
    volatile LAS unsigned* st;
};

__device__ __forceinline__ XcdBarrier xcd_barrier_post(unsigned* bar, volatile LAS unsigned* st) {
    XcdBarrier b; b.bar = bar; b.x = xb_xcc_id(); b.st = st;
    if (threadIdx.x == 0) (void)xb_add(&bar[XB_XCNT(b.x)], 1u);
    return b;
}
__device__ __forceinline__ void xcd_barrier_complete(unsigned* bar, unsigned x, unsigned& nloc, unsigned& nx) {
    const unsigned G = gridDim.x * gridDim.y * gridDim.z;
    unsigned sum, cnt, mine, sp = 0u;
    for (;;) {
        sum = 0u; cnt = 0u; mine = 0u;
#pragma unroll
        for (unsigned j = 0; j < 16; ++j) { const unsigned c = xb_ld(&bar[XB_XCNT(j)]); sum += c; cnt += (c > 0u) ? 1u : 0u; mine = (j == x) ? c : mine; }
        if (sum == G) break;
        __builtin_amdgcn_s_sleep(1);
        if ((++sp & 255u) == 0u) { if (xb_ld(&bar[XB_TMO])) break; if (sp > XB_SPIN_CAP) { atomicAdd(&bar[XB_TMO], 1u); break; } }
    }
    nloc = mine > 0u ? mine : 1u; nx = cnt > 0u ? cnt : 1u;
}

__device__ __forceinline__ void xcd_barrier(const XcdBarrier& b) {
    asm volatile("s_waitcnt vmcnt(0)" ::: "memory");
    __syncthreads();
    if (threadIdx.x == 0) {
        unsigned* bar = b.bar;
        __builtin_amdgcn_s_waitcnt(0);
        unsigned nloc = b.st[0], nx = b.st[1];
        if (nloc == 0u) { xcd_barrier_complete(bar, b.x, nloc, nx); b.st[0] = nloc; b.st[1] = nx; }
        const unsigned old = xb_add(&bar[XB_XSUB(b.x)], 1u);
        const unsigned gen = old / nloc;
        if (old + 1u == (gen + 1u) * nloc) {
            __builtin_amdgcn_fence(__ATOMIC_RELEASE, "agent");
            asm volatile("s_waitcnt vmcnt(0)" ::: "memory");
            const unsigned og = xb_add(&bar[XB_TOP], 1u);
            const unsigned tg = og / nx;
            if (og + 1u == (tg + 1u) * nx) xb_add(&bar[XB_TOPGEN], 1u);
            else XB_SPIN(xb_ld(&bar[XB_TOPGEN]) == tg, bar);
            __builtin_amdgcn_fence(__ATOMIC_ACQUIRE, "agent");
            xb_add(&bar[XB_XGEN(b.x)], 1u);
            asm volatile("s_waitcnt vmcnt(0)" ::: "memory");
        } else {
            XB_SPIN(xb_ld(&bar[XB_XGEN(b.x)]) == gen, bar);
            __builtin_amdgcn_fence(__ATOMIC_ACQUIRE, "agent");
            asm volatile("s_waitcnt vmcnt(0)" ::: "memory");
        }
    }
    __syncthreads();
}

struct Ctx {
    const float* in[23]; float* out; unsigned char* ws;
    LAS unsigned char* lds;
};
struct Ids { int tid, lane, wave, gw, ngw; };
__device__ __forceinline__ Ids phase_ids() { Ids I; int t = threadIdx.x; asm volatile("" : "+v"(t)); I.tid = t; I.lane = t & 63; I.wave = __builtin_amdgcn_readfirstlane(t >> 6); I.gw = (int)blockIdx.x * 8 + I.wave; I.ngw = (int)gridDim.x * 8; return I; }
template <class T> __device__ __forceinline__ T* wsp(const Ctx& C, size_t off) { return (T*)(C.ws + off); }

__device__ __forceinline__ void phase_prologue(const Ctx& C) {
    const Ids I = phase_ids();
    LAS float* scr = (LAS float*)(C.lds + I.wave * 16384);
    const int gw = I.gw, ngw = I.ngw, lane = I.lane;
    const float* win0 = C.in[1]; const float* win1 = C.in[14];
    transpose_matrix(win0, 2048, 1024, 1024, wsp<bf16_t>(C, WS_WQKU0), 0, 0, scr, gw, ngw, lane);
    transpose_matrix(win0 + 1536, 2048, 1024, 512, wsp<bf16_t>(C, WS_WQKU0), 1024, 0, scr, gw, ngw, lane);
    transpose_matrix(win0 + 1024, 2048, 1024, 512, wsp<bf16_t>(C, WS_WV0), 0, 0, scr, gw, ngw, lane);
    transpose_matrix(C.in[11], 512, 512, 512, wsp<bf16_t>(C, WS_WGLU), 0, 0, scr, gw, ngw, lane);
    transpose_matrix(C.in[13], 1024, 1024, 1024, wsp<bf16_t>(C, WS_WOUT0), 0, 0, scr, gw, ngw, lane);
    transpose_matrix(win1, 3072, 1024, 2048, wsp<bf16_t>(C, WS_WQK1), 0, 0, scr, gw, ngw, lane);
    transpose_matrix(win1 + 2048, 3072, 1024, 1024, wsp<bf16_t>(C, WS_WV1), 0, 0, scr, gw, ngw, lane);
    transpose_matrix(C.in[15], 1024, 1024, 1024, wsp<bf16_t>(C, WS_WOUT1), 0, 0, scr, gw, ngw, lane);
#pragma unroll 1
    for (int l = 0; l < 2; ++l) {
        transpose_matrix(C.in[16] + (size_t)l * DM * DFF, DFF, 1024, DFF, wsp<bf16_t>(C, l ? WS_W13_1 : WS_W13_0), 0, 1, scr, gw, ngw, lane);
        transpose_matrix(C.in[17] + (size_t)l * DM * DFF, DFF, 1024, DFF, wsp<bf16_t>(C, l ? WS_W13_1 : WS_W13_0), 0, 2, scr, gw, ngw, lane);
        transpose_matrix(C.in[18] + (size_t)l * DM * DFF, 1024, DFF, 1024, wsp<bf16_t>(C, l ? WS_W2_1 : WS_W2_0), 0, 0, scr, gw, ngw, lane);
    }
    { const float* x = C.in[0]; bf16_t* xb = wsp<bf16_t>(C, WS_HB); const size_t n8 = (size_t)MTOK * DM / 8, gt = (size_t)blockIdx.x * 512 + I.tid, nt = (size_t)gridDim.x * 512;
      for (size_t i = gt; i < n8; i += nt) { const f32x4 a = *(const f32x4*)(x + i * 8), b = *(const f32x4*)(x + i * 8 + 4); u32x4 w; w.x = pk2(a[0], a[1]); w.y = pk2(a[2], a[3]); w.z = pk2(b[0], b[1]); w.w = pk2(b[2], b[3]); *(u32x4*)(xb + i * 8) = w; } }
    { const int gt = blockIdx.x * 512 + I.tid;
      if (gt < NGRP * NST) { const int g = gt / NST, p = gt % NST;
        const float dt = expf(C.in[10][g]); const float lr = C.in[3][gt], li = C.in[4][gt];
        const float a = lr * dt, b = li * dt; float sb, cb, sh, ch; sincos_f(b, sb, cb); sincos_f(0.5f * b, sh, ch);
        const float mag = expf(a), em1 = expm1f(a);
        const float ar = mag * cb, ai = mag * sb, ar1 = em1 * cb - 2.0f * sh * sh;
        const float den = lr * lr + li * li; const float fr = (ar1 * lr + ai * li) / den, fi = (ai * lr - ar1 * li) / den;
        f32x2* abar = wsp<f32x2>(C, WS_S5P + S5P_ABAR); f32x2* al = wsp<f32x2>(C, WS_S5P + S5P_AL); abar[gt] = (f32x2){ar, ai};
        float pr = ar, pi = ai;
#pragma unroll
        for (int s = 0; s < 6; ++s) { const float nr = pr * pr - pi * pi, ni = 2.0f * pr * pi; pr = nr; pi = ni; }
        al[gt] = (f32x2){pr, pi};
        f32x2* bbar = wsp<f32x2>(C, WS_S5P + S5P_BBAR) + (size_t)gt * GCH; const float* bre = C.in[5] + (size_t)gt * GCH; const float* bim = C.in[6] + (size_t)gt * GCH;
#pragma unroll
        for (int i = 0; i < GCH; ++i) bbar[i] = (f32x2){fr * bre[i] - fi * bim[i], fr * bim[i] + fi * bre[i]};
        bf16_t* cm = wsp<bf16_t>(C, WS_S5P + S5P_CMAT) + (size_t)g * GCH * 128; const float* cre = C.in[7] + (size_t)g * GCH * NST; const float* cim = C.in[8] + (size_t)g * GCH * NST;
#pragma unroll
        for (int i = 0; i < GCH; ++i) { cm[i * 128 + p] = (bf16_t)(pk2(cre[i * NST + p], 0.f) & 0xffff); cm[i * 128 + 64 + p] = (bf16_t)(pk2(-cim[i * NST + p], 0.f) & 0xffff); } }
      if (gt < 8 * 257) { const int h = gt / 257, i = gt % 257; wsp<float>(C, WS_S5P + S5P_BIAS)[h * BIAS_LD + i] = C.in[2][gt] * LOG2E; } }
}

__device__ __forceinline__ void phase_ln(const Ctx& C, float* buf, bf16_t* hb, const float* g, const float* b) {
    const Ids I = phase_ids();
    f32x4 gv[4], bv[4];
#pragma unroll
    for (int j = 0; j < 4; ++j) { gv[j] = *(const f32x4*)(g + 4 * I.lane + 256 * j); bv[j] = *(const f32x4*)(b + 4 * I.lane + 256 * j); }
    for (int m = I.gw; m < MTOK; m += I.ngw) {
        float* row = buf + (size_t)m * DM + 4 * I.lane; f32x4 v[4]; float s = 0.f;
#pragma unroll
        for (int j = 0; j < 4; ++j) { v[j] = *(const f32x4*)(row + 256 * j); s += (v[j][0] + v[j][1]) + (v[j][2] + v[j][3]); }
#pragma unroll
        for (int o = 1; o < 64; o <<= 1) s += __shfl_xor(s, o);
        const float mean = s * (1.0f / DM); float q = 0.f;
#pragma unroll
        for (int j = 0; j < 4; ++j) { v[j] = v[j] - mean; q += (v[j][0] * v[j][0] + v[j][1] * v[j][1]) + (v[j][2] * v[j][2] + v[j][3] * v[j][3]); }
#pragma unroll
        for (int o = 1; o < 64; o <<= 1) q += __shfl_xor(q, o);
        const float rstd = 1.0f / sqrtf(q * (1.0f / DM) + LN_EPS);
        bf16_t* hrow = hb + (size_t)m * DM + 4 * I.lane;
#pragma unroll
        for (int j = 0; j < 4; ++j) { const f32x4 y = v[j] * rstd * gv[j] + bv[j]; *(f32x4*)(row + 256 * j) = y; u32x2 w; w.x = pk2(y[0], y[1]); w.y = pk2(y[2], y[3]); *(u32x2*)(hrow + 256 * j) = w; }
    }
}

constexpr int S5_WAVE_LDS = 4096 + 8704, S5_XLD = 136;
__device__ __forceinline__ void s5_load_u(const Ctx& C, const Ids& I, LAS float* ut, const bf16_t* proj, int b, int g, int c) {
    const bf16_t* up = proj + (size_t)(b * SEQ + c * 64 + I.lane) * 1536 + 1024 + g * GCH;
    const u32x4 a = *(const u32x4*)up, d = *(const u32x4*)(up + 8);
    LAS f32x4* dst = (LAS f32x4*)(ut + I.lane * 16);
    dst[0] = (f32x4){bf2f(a.x & 0xffff), bf2f(a.x >> 16), bf2f(a.y & 0xffff), bf2f(a.y >> 16)}; dst[1] = (f32x4){bf2f(a.z & 0xffff), bf2f(a.z >> 16), bf2f(a.w & 0xffff), bf2f(a.w >> 16)};
    dst[2] = (f32x4){bf2f(d.x & 0xffff), bf2f(d.x >> 16), bf2f(d.y & 0xffff), bf2f(d.y >> 16)}; dst[3] = (f32x4){bf2f(d.z & 0xffff), bf2f(d.z >> 16), bf2f(d.w & 0xffff), bf2f(d.w >> 16)};
    asm volatile("s_waitcnt lgkmcnt(0)" ::: "memory");
}
#define S5_STEP(t) do { const LAS f32x4* ur = (const LAS f32x4*)(ut + (t) * 16); const f32x4 u0 = ur[0], u1 = ur[1], u2 = ur[2], u3 = ur[3]; \
    f32x2 bu = bb[0] * u0[0]; bu += bb[1] * u0[1]; bu += bb[2] * u0[2]; bu += bb[3] * u0[3]; bu += bb[4] * u1[0]; bu += bb[5] * u1[1]; bu += bb[6] * u1[2]; bu += bb[7] * u1[3]; \
    bu += bb[8] * u2[0]; bu += bb[9] * u2[1]; bu += bb[10] * u2[2]; bu += bb[11] * u2[3]; bu += bb[12] * u3[0]; bu += bb[13] * u3[1]; bu += bb[14] * u3[2]; bu += bb[15] * u3[3]; \
    const float nr = A.x * xr - A.y * xi + bu.x, ni = A.x * xi + A.y * xr + bu.y; xr = nr; xi = ni; } while (0)

__device__ __forceinline__ void phase_s5a(const Ctx& C) {
    const Ids I = phase_ids();
    LAS float* ut = (LAS float*)(C.lds + I.wave * S5_WAVE_LDS);
    const bf16_t* proj = wsp<bf16_t>(C, WS_PROJ); f32x2* S = wsp<f32x2>(C, WS_S5S);
    for (int it = I.gw; it < NB * NGRP * NCHK; it += I.ngw) {
        const int c = it % NCHK, g = (it / NCHK) % NGRP, b = it / (NCHK * NGRP);
        const f32x2 A = wsp<f32x2>(C, WS_S5P + S5P_ABAR)[g * NST + I.lane];
        f32x2 bb[16]; { const f32x4* bp = (const f32x4*)(wsp<f32x2>(C, WS_S5P + S5P_BBAR) + (size_t)(g * NST + I.lane) * GCH);
#pragma unroll
            for (int i = 0; i < 8; ++i) { const f32x4 t = bp[i]; bb[2 * i] = (f32x2){t[0], t[1]}; bb[2 * i + 1] = (f32x2){t[2], t[3]}; } }
        s5_load_u(C, I, ut, proj, b, g, c);
        float xr = 0.f, xi = 0.f;
#pragma unroll 4
        for (int t = 0; t < 64; ++t) S5_STEP(t);
        S[(size_t)it * NST + I.lane] = (f32x2){xr, xi};
        asm volatile("s_waitcnt lgkmcnt(0)" ::: "memory");
    }
}
__device__ __forceinline__ void phase_s5b(const Ctx& C) {
    const Ids I = phase_ids();
    const f32x2* S = wsp<f32x2>(C, WS_S5S); f32x2* X = wsp<f32x2>(C, WS_S5X);
    for (int it = I.gw; it < NB * NGRP; it += I.ngw) {
        const int g = it % NGRP; const f32x2 AL = wsp<f32x2>(C, WS_S5P + S5P_AL)[g * NST + I.lane];
        float xr = 0.f, xi = 0.f; const size_t base = (size_t)it * NCHK * NST + I.lane;
#pragma unroll 1
        for (int c0 = 0; c0 < NCHK; c0 += 16) { f32x2 s[16];
#pragma unroll
            for (int j = 0; j < 16; ++j) s[j] = S[base + (size_t)(c0 + j) * NST];
#pragma unroll
            for (int j = 0; j < 16; ++j) { X[base + (size_t)(c0 + j) * NST] = (f32x2){xr, xi}; const float nr = AL.x * xr - AL.y * xi + s[j].x, ni = AL.x * xi + AL.y * xr + s[j].y; xr = nr; xi = ni; } }
    }
}
__device__ __forceinline__ void phase_s5c(const Ctx& C) {
    const Ids I = phase_ids();
    LAS float* ut = (LAS float*)(C.lds + I.wave * S5_WAVE_LDS); LAS bf16_t* xt = (LAS bf16_t*)(C.lds + I.wave * S5_WAVE_LDS + 4096);
    const bf16_t* proj = wsp<bf16_t>(C, WS_PROJ); const f32x2* Xin = wsp<f32x2>(C, WS_S5X); bf16_t* YG = wsp<bf16_t>(C, WS_YG);
    const int l16 = I.lane & 15, kq = I.lane >> 4;
    for (int it = I.gw; it < NB * NGRP * NCHK; it += I.ngw) {
        const int c = it % NCHK, g = (it / NCHK) % NGRP, b = it / (NCHK * NGRP);
        const f32x2 A = wsp<f32x2>(C, WS_S5P + S5P_ABAR)[g * NST + I.lane];
        f32x2 bb[16]; { const f32x4* bp = (const f32x4*)(wsp<f32x2>(C, WS_S5P + S5P_BBAR) + (size_t)(g * NST + I.lane) * GCH);
#pragma unroll
            for (int i = 0; i < 8; ++i) { const f32x4 t = bp[i]; bb[2 * i] = (f32x2){t[0], t[1]}; bb[2 * i + 1] = (f32x2){t[2], t[3]}; } }
        bf16x8 cf[4]; { const bf16_t* cm = wsp<bf16_t>(C, WS_S5P + S5P_CMAT) + (size_t)(g * GCH + l16) * 128 + 8 * kq;
#pragma unroll
            for (int ks = 0; ks < 4; ++ks) cf[ks] = *(const bf16x8*)(cm + ks * 32); }
        const f32x4 dsk = *(const f32x4*)(C.in[9] + g * GCH + 4 * kq);
        s5_load_u(C, I, ut, proj, b, g, c);
        const f32x2 x0 = Xin[(size_t)it * NST + I.lane]; float xr = x0.x, xi = x0.y;
#pragma unroll 1
        for (int half = 0; half < 2; ++half) {
#pragma unroll 4
            for (int tt = 0; tt < 32; ++tt) { S5_STEP(half * 32 + tt);
                const unsigned w = pk2(xr, xi); xt[tt * S5_XLD + I.lane] = (bf16_t)(w & 0xffff); xt[tt * S5_XLD + 64 + I.lane] = (bf16_t)(w >> 16); }
            asm volatile("s_waitcnt lgkmcnt(0)" ::: "memory");
#pragma unroll
            for (int tb = 0; tb < 2; ++tb) { f32x4 acc = {0.f, 0.f, 0.f, 0.f};
#pragma unroll
                for (int ks = 0; ks < 4; ++ks) { const bf16x8 xf = *(const LAS bf16x8*)(xt + (tb * 16 + l16) * S5_XLD + ks * 32 + 8 * kq); acc = __builtin_amdgcn_mfma_f32_16x16x32_bf16(cf[ks], xf, acc, 0, 0, 0); }
                const int t = half * 32 + tb * 16 + l16; const f32x4 uu = *(const LAS f32x4*)(ut + t * 16 + 4 * kq);
                float y[4];
#pragma unroll
                for (int e = 0; e < 4; ++e) { const float v = acc[e] + dsk[e] * uu[e]; const float z = 1.5957691216057308f * (v + 0.044715f * v * v * v); y[e] = v * fast_rcp(1.0f + fast_exp2(-z * LOG2E)); }
                u32x2 w; w.x = pk2(y[0], y[1]); w.y = pk2(y[2], y[3]);
                *(u32x2*)(YG + (size_t)(b * SEQ + c * 64 + t) * 512 + g * GCH + 4 * kq) = w; }
            asm volatile("s_waitcnt lgkmcnt(0)" ::: "memory");
        }
    }
}

__device__ __forceinline__ int crow(int r, int hi) { return (r & 3) + 8 * (r >> 2) + 4 * hi; }
__device__ __forceinline__ f32x16 qk32(const bf16_t* kp, const bf16x8 (&qr)[4]) {
    f32x16 p = {0.f, 0.f, 0.f, 0.f, 0.f, 0.f, 0.f, 0.f, 0.f, 0.f, 0.f, 0.f, 0.f, 0.f, 0.f, 0.f};
#pragma unroll
    for (int d0 = 0; d0 < 4; ++d0) { const bf16x8 kf = *(const bf16x8*)(kp + d0 * 16); p = __builtin_amdgcn_mfma_f32_32x32x16_bf16(kf, qr[d0], p, 0, 0, 0); }
    return p;
}
__device__ __forceinline__ bf16x8 pack8(const f32x16& p, int s) {
    u32x4 w; w.x = pk2(p[8 * s + 0], p[8 * s + 1]); w.y = pk2(p[8 * s + 2], p[8 * s + 3]); w.z = pk2(p[8 * s + 4], p[8 * s + 5]); w.w = pk2(p[8 * s + 6], p[8 * s + 7]);
    return __builtin_bit_cast(bf16x8, w);
}
__device__ __forceinline__ void pv64(f32x16 (&o)[2], const bf16_t* vt, size_t vstride32, const f32x16& p0, const f32x16& p1) {
#pragma unroll
    for (int ks = 0; ks < 4; ++ks) { const bf16x8 pb = (ks < 2) ? pack8(p0, ks & 1) : pack8(p1, ks & 1);
#pragma unroll
        for (int db = 0; db < 2; ++db) { const bf16_t* vp = vt + db * vstride32 + 32 * (ks >> 1) + 16 * (ks & 1);
            const u32x2 lo = *(const u32x2*)vp, hi = *(const u32x2*)(vp + 8); const u32x4 w = {lo.x, lo.y, hi.x, hi.y};
            o[db] = __builtin_amdgcn_mfma_f32_32x32x16_bf16(__builtin_bit_cast(bf16x8, w), pb, o[db], 0, 0, 0); } }
}
__device__ __forceinline__ void store_ot(bf16_t* orow, const f32x16 (&o)[2], float sc, int hi) {
#pragma unroll
    for (int db = 0; db < 2; ++db)
#pragma unroll
        for (int a = 0; a < 4; ++a) { u32x2 w; w.x = pk2(o[db][4 * a] * sc, o[db][4 * a + 1] * sc); w.y = pk2(o[db][4 * a + 2] * sc, o[db][4 * a + 3] * sc); *(u32x2*)(orow + db * 32 + 8 * a + 4 * hi) = w; }
}
__device__ __forceinline__ float half_lo(float v, float& up) { auto rr = __builtin_amdgcn_permlane32_swap(__float_as_uint(v), __float_as_uint(v), false, false); up = __uint_as_float(rr[1]); return __uint_as_float(rr[0]); }

__device__ __forceinline__ void phase_chunk_attn(const Ctx& C) {
    const Ids I = phase_ids();
    const bf16_t* proj = wsp<bf16_t>(C, WS_PROJ); const bf16_t* VT = wsp<bf16_t>(C, WS_VT); bf16_t* MIX = wsp<bf16_t>(C, WS_MIX);
    LAS float* btab = (LAS float*)(C.lds + 104448);
    { const float* src = wsp<float>(C, WS_S5P + S5P_BIAS); for (int i = I.tid; i < 8 * BIAS_LD; i += 512) btab[i] = ((i % BIAS_LD) < 257) ? src[i] : 0.f; }
    __syncthreads();
    const int r32 = I.lane & 31, hi = I.lane >> 5;
    for (int it = I.gw; it < NB * 128 * 8 * 2; it += I.ngw) {
        const int qh = it & 1, h = (it >> 1) & 7, c = (it >> 4) & 127, b = it >> 11;
        const int q0 = c * 64 + qh * 32;
        const size_t rowq = (size_t)b * SEQ + q0 + r32;
        bf16x8 qr[4];
#pragma unroll
        for (int d0 = 0; d0 < 4; ++d0) qr[d0] = *(const bf16x8*)(proj + rowq * 1536 + h * 64 + d0 * 16 + 8 * hi);
        const LAS float* tb = btab + h * BIAS_LD;
        f32x16 o[2]; o[0] = (f32x16){0.f, 0.f, 0.f, 0.f, 0.f, 0.f, 0.f, 0.f, 0.f, 0.f, 0.f, 0.f, 0.f, 0.f, 0.f, 0.f}; o[1] = o[0];
        float m = -1e30f, l = 0.f;
        const int qpos = q0 + r32;
#pragma unroll 1
        for (int kc = (c >= 8 ? c - 8 : 0); kc <= c; ++kc) {
            const int kb = kc * 64;
            const bf16_t* kp = proj + ((size_t)b * SEQ + kb + r32) * 1536 + 512 + h * 64 + 8 * hi;
            f32x16 p0 = qk32(kp, qr), p1 = qk32(kp + (size_t)32 * 1536, qr);
            float mx = -1e30f;
#pragma unroll
            for (int r = 0; r < 16; ++r) { const int d0 = qpos - (kb + crow(r, hi)); const int i0 = min(max(d0, -128), 128) + 128, i1 = min(max(d0 - 32, -128), 128) + 128;
                p0[r] += tb[i0]; p1[r] += tb[i1]; mx = fmaxf(mx, fmaxf(p0[r], p1[r])); }
            { float up; const float lo = half_lo(mx, up); mx = fmaxf(lo, up); }
            const float mn = fmaxf(m, mx), alpha = fast_exp2(m - mn); m = mn;
            float ls = 0.f;
#pragma unroll
            for (int r = 0; r < 16; ++r) { p0[r] = fast_exp2(p0[r] - mn); p1[r] = fast_exp2(p1[r] - mn); ls += p0[r] + p1[r]; }
            l = l * alpha + ls;
#pragma unroll
            for (int r = 0; r < 16; ++r) { o[0][r] *= alpha; o[1][r] *= alpha; }
            pv64(o, VT + (size_t)(h * 64 + r32) * MTOK + (size_t)b * SEQ + kb + 4 * hi, (size_t)32 * MTOK, p0, p1);
        }
        { float up; const float lo = half_lo(l, up); l = lo + up; }
        store_ot(MIX + rowq * DM + h * 64, o, fast_rcp(l), hi);
    }
}

__device__ __forceinline__ void sb_suffix(f32x16& v, float& carry, int hi) {
    float tot[4], oth[4];
#pragma unroll
    for (int a = 0; a < 4; ++a) { const float s3 = v[4 * a + 3], s2 = v[4 * a + 2] + s3, s1 = v[4 * a + 1] + s2, s0 = v[4 * a] + s1; v[4 * a + 3] = s3; v[4 * a + 2] = s2; v[4 * a + 1] = s1; v[4 * a] = s0;
        float up; const float lo = half_lo(s0, up); tot[a] = lo + up; oth[a] = up; }
    float T = carry;
#pragma unroll
    for (int a = 3; a >= 0; --a) { const float base = T + (hi == 0 ? oth[a] : 0.f); v[4 * a] += base; v[4 * a + 1] += base; v[4 * a + 2] += base; v[4 * a + 3] += base; T += tot[a]; }
    carry = T;
}
__device__ __forceinline__ void phase_sb_attn(const Ctx& C) {
    const Ids I = phase_ids();
    const bf16_t* proj = wsp<bf16_t>(C, WS_PROJ); const bf16_t* VT = wsp<bf16_t>(C, WS_VT); bf16_t* MIX = wsp<bf16_t>(C, WS_MIX);
    const int r32 = I.lane & 31, hi = I.lane >> 5;
    for (int it = I.gw; it < NB * 16 * 256; it += I.ngw) {
        const int h = it & 15, qb = 255 - ((it >> 4) & 255), b = it >> 12;
        const int q0 = qb * 32, tq = q0 + r32;
        const size_t rowq = (size_t)b * SEQ + q0 + r32;
        bf16x8 qr[4];
#pragma unroll
        for (int d0 = 0; d0 < 4; ++d0) qr[d0] = *(const bf16x8*)(proj + rowq * 2048 + h * 64 + d0 * 16 + 8 * hi);
        f32x16 o[2]; o[0] = (f32x16){0.f, 0.f, 0.f, 0.f, 0.f, 0.f, 0.f, 0.f, 0.f, 0.f, 0.f, 0.f, 0.f, 0.f, 0.f, 0.f}; o[1] = o[0];
        float carry = 0.f;
#pragma unroll 1
        for (int kb = (q0 >> 6) << 6; kb >= 0; kb -= 64) {
            const bf16_t* kp = proj + ((size_t)b * SEQ + kb + r32) * 2048 + 1024 + h * 64 + 8 * hi;
            f32x16 z0 = qk32(kp, qr), z1 = qk32(kp + (size_t)32 * 2048, qr);
            f32x16 s0, s1;
#pragma unroll
            for (int r = 0; r < 16; ++r) { const int k0 = kb + crow(r, hi);
                const float a0 = z0[r], a1 = z1[r];
                const float sp0 = fmaxf(a0, 0.f) + fast_log2(1.0f + fast_exp2(-fabsf(a0))), sp1 = fmaxf(a1, 0.f) + fast_log2(1.0f + fast_exp2(-fabsf(a1)));
                s0[r] = (k0 < tq) ? sp0 : 0.f; s1[r] = (k0 + 32 < tq) ? sp1 : 0.f; }
            sb_suffix(s1, carry, hi); sb_suffix(s0, carry, hi);
#pragma unroll
            for (int r = 0; r < 16; ++r) { const int k0 = kb + crow(r, hi);
                z0[r] = (k0 < tq) ? fast_exp2(z0[r] - s0[r]) : 0.f; z1[r] = (k0 + 32 < tq) ? fast_exp2(z1[r] - s1[r]) : 0.f; }
            pv64(o, VT + (size_t)(h * 64 + r32) * MTOK + (size_t)b * SEQ + kb + 4 * hi, (size_t)32 * MTOK, z0, z1);
            if (__all(carry >= 150.0f)) break;
        }
        store_ot(MIX + rowq * DM + h * 64, o, 1.0f, hi);
    }
}

struct Params { const float* in[23]; float* out; unsigned char* ws; };
#define GSYNC() xcd_barrier(bar)
template <int K, class Epi> __device__ __forceinline__ void run_gemm(const Ctx& C, const bf16_t* A, const bf16_t* Bt, int M, int N, const Epi& E) {
    pg8::Gemm g{A, Bt, M, N, K}; pg8::StaticOrder S; S.init(M, N, (int)gridDim.x, (int)blockIdx.x);
    pg8::gemm_phase<Epi, pg8::StaticOrder, true, true, K>(C.lds, g, S, E);
}
__global__ void __launch_bounds__(512, 2) fwd_megakernel(Params P) {
    extern __shared__ __attribute__((aligned(16))) unsigned char lds_raw[];
    cg::grid_group grid = cg::this_grid();
    Ctx C;
#pragma unroll
    for (int i = 0; i < 23; ++i) C.in[i] = P.in[i];
    C.out = P.out; C.ws = P.ws; C.lds = (LAS unsigned char*)lds_raw;
    volatile LAS unsigned* bst = (volatile LAS unsigned*)(C.lds + 131072);
    if (threadIdx.x < 64) bst[threadIdx.x] = 0u;
    __syncthreads();
    XcdBarrier bar = xcd_barrier_post((unsigned*)C.ws + 4096, bst + 8);
    grid.sync();
    bf16_t* HB = wsp<bf16_t>(C, WS_HB); bf16_t* PROJ = wsp<bf16_t>(C, WS_PROJ); bf16_t* VT = wsp<bf16_t>(C, WS_VT); bf16_t* MIX = wsp<bf16_t>(C, WS_MIX); bf16_t* HID = wsp<bf16_t>(C, WS_HID);

    for (int rep_ = 0; rep_ < REP_PRO; ++rep_) phase_prologue(C);
    for (int rep_ = 0; rep_ < REP_SYNC; ++rep_) GSYNC();
#pragma unroll
    for (int layer = 0; layer < 2; ++layer) {
        { const int nqk = layer ? 2048 : 1536, nv = layer ? 1024 : 512;
          EpiStoreBf16 E1{PROJ, nqk, layer ? 1024 : 512, QSCALE};
          run_gemm<1024>(C, HB, wsp<bf16_t>(C, layer ? WS_WQK1 : WS_WQKU0), MTOK, nqk, E1);
          EpiStoreBf16 E2{VT, MTOK, 0, 1.0f};
          run_gemm<1024>(C, wsp<bf16_t>(C, layer ? WS_WV1 : WS_WV0), HB, nv, MTOK, E2); }
        GSYNC();
        if (layer == 0) {
            for (int rep_ = 0; rep_ < REP_S5; ++rep_) phase_s5a(C);
            GSYNC();
            phase_s5b(C);
            for (int rep_ = 0; rep_ < REP_CA; ++rep_) phase_chunk_attn(C);
            GSYNC();
            for (int rep_ = 0; rep_ < REP_S5; ++rep_) phase_s5c(C);
            GSYNC();
            { EpiGlu E{wsp<bf16_t>(C, WS_YG), C.in[12], MIX}; run_gemm<512>(C, wsp<bf16_t>(C, WS_YG), wsp<bf16_t>(C, WS_WGLU), MTOK, 512, E); }
        } else {
            for (int rep_ = 0; rep_ < REP_SB; ++rep_) phase_sb_attn(C);
        }
        GSYNC();
        { EpiResF32 E{layer ? C.out : C.in[0], C.out, ALPHA}; run_gemm<1024>(C, MIX, wsp<bf16_t>(C, layer ? WS_WOUT1 : WS_WOUT0), MTOK, DM, E); }
        GSYNC();
        phase_ln(C, C.out, HB, C.in[19] + layer * DM, C.in[20] + layer * DM);
        GSYNC();
        { EpiSwiglu E{HID, DFF}; run_gemm<1024>(C, HB, wsp<bf16_t>(C, layer ? WS_W13_1 : WS_W13_0), MTOK, 2 * DFF, E); }
        GSYNC();
        { EpiResF32 E{C.out, C.out, ALPHA}; run_gemm<2816>(C, HID, wsp<bf16_t>(C, layer ? WS_W2_1 : WS_W2_0), MTOK, DM, E); }
        GSYNC();
        phase_ln(C, C.out, HB, C.in[21] + layer * DM, C.in[22] + layer * DM);
        if (layer == 0) GSYNC();
    }
}

extern "C" void kernel_launch(void* const* d_in, const int* in_sizes, int n_in, void* d_out, int out_size, void* d_ws, size_t ws_size, hipStream_t stream) {
    static int grid = 0;
    if (grid == 0) {
        if (n_in != 23 || out_size != MTOK * DM || ws_size < WS_END) { fprintf(stderr, "kernel_launch: unexpected shapes (n_in %d, out %d, ws %zu)\n", n_in, out_size, ws_size); grid = -1; return; }
        int dev = 0, cus = 0, per_cu = 0;
        hipGetDevice(&dev); hipDeviceGetAttribute(&cus, hipDeviceAttributeMultiprocessorCount, dev);
        hipFuncSetAttribute((const void*)fwd_megakernel, hipFuncAttributeMaxDynamicSharedMemorySize, LDS_BYTES);
        hipOccupancyMaxActiveBlocksPerMultiprocessor(&per_cu, (const void*)fwd_megakernel, 512, LDS_BYTES);
        if (per_cu < 1) { fprintf(stderr, "kernel_launch: occupancy query says %d blocks per CU\n", per_cu); per_cu = 1; }
        grid = cus * 1;
        (void)hipGetLastError();
    }
    if (grid < 0) return;
    if (hipMemsetAsync(d_ws, 0, 1u << 20, stream) != hipSuccess) { fprintf(stderr, "kernel_launch: memset failed\n"); return; }
    Params p{};
    for (int i = 0; i < 23; ++i) p.in[i] = (const float*)d_in[i];
    p.out = (float*)d_out; p.ws = (unsigned char*)d_ws;
    void* args[] = {&p};
    hipError_t e = hipLaunchCooperativeKernel((const void*)fwd_megakernel, dim3(grid), dim3(512), args, LDS_BYTES, stream);
    if (e != hipSuccess) fprintf(stderr, "cooperative launch failed: %s (grid %d)\n", hipGetErrorString(e), grid);
}
```

```cpp
#include <hip/hip_runtime.h>
#include <hip/hip_cooperative_groups.h>
#include <cstdio>
#include <cstdint>
namespace cg = cooperative_groups;
#ifndef REP_PRO
#define REP_PRO 1
#define REP_S5 1
#define REP_CA 1
#define REP_SB 1
#define REP_SYNC 1
#endif
namespace pg8 {
#define PG8_LAS __attribute__((address_space(3)))
typedef unsigned short bf16_t;
typedef short bf16x8 __attribute__((ext_vector_type(8)));
typedef float f32x4 __attribute__((ext_vector_type(4)));
typedef unsigned u32x4 __attribute__((ext_vector_type(4)));
constexpr int BM = 256, BK = 64, HALF = 128, HTB = HALF * BK * 2  , STAGE_BYTES = 8 * HTB, NXCD = 8, WGM = 8;

__host__ __device__ __forceinline__ int lds_byte(int r, int c) { const int st = (r >> 4) * 2 + (c >> 5), rr = r & 15, cc = c & 31, ob = rr * 64 + cc * 2; return st * 1024 + (ob ^ (((ob >> 9) & 1) << 5)); }
__host__ __device__ __forceinline__ void stage_rc(int b, int& R, int& C) { const int st = b / 1024, sb = b % 1024, swz = sb ^ (((sb >> 9) & 1) << 5); R = (st >> 1) * 16 + swz / 64; C = (st & 1) * 32 + (swz % 64) / 2; }
__host__ __device__ __forceinline__ int perm32(int rho) { const int n = rho >> 4, i = rho & 15; return 8 * (i >> 2) + 4 * n + (i & 3); }

struct Unit { int pm, pn; };
struct Gemm { const bf16_t* A; const bf16_t* Bt; int M, N, K; };

struct StaticOrder {
    int nM, nN, nwg, G, c;
    __host__ __device__ void init(int M, int N, int G_, int c_) { nM = M / BM; nN = N / BM; nwg = nM * nN; G = G_; c = c_; }
    __host__ __device__ bool next(int i, Unit& u) const {
        const long L = (long)i * G + c; if (L >= nwg) return false;
        int wgid = (int)L; { const int q = nwg / NXCD, r = nwg % NXCD, xcd = wgid % NXCD, off = wgid / NXCD; wgid = (xcd < r ? xcd * (q + 1) : r * (q + 1) + (xcd - r) * q) + off; }
        const int nig = WGM * nN, gid = wgid / nig, fm = gid * WGM, gsz = (nM - fm) < WGM ? (nM - fm) : WGM;
        u.pm = fm + ((wgid % nig) % gsz); u.pn = (wgid % nig) / gsz; return true;
    }
    __device__ __forceinline__ void a_ready(const Unit&) const {}
    __device__ __forceinline__ void done(const Unit&) const {}
};

__device__ __forceinline__ unsigned cvt_pk_bf16(float lo, float hi) { unsigned r; asm volatile("v_cvt_pk_bf16_f32 %0, %1, %2" : "=v"(r) : "v"(lo), "v"(hi)); return r; }
typedef float f32x2 __attribute__((ext_vector_type(2)));
template <class Epi, class Sched, bool ALIGN_EPI, bool SP2, int KC>
__device__ __forceinline__ void gemm_phase(PG8_LAS unsigned char* lds, const Gemm g, const Sched& S, const Epi& E) {
    int tid_ = threadIdx.x; asm volatile("" : "+v"(tid_)); const int tid = tid_, wid = __builtin_amdgcn_readfirstlane(tid >> 6), lane = tid & 63, wr = wid >> 2, wc = wid & 3, fr = lane & 15, fq = lane >> 4;
    constexpr int K = KC, nt = K / BK;
    unsigned voffA[2], voffB[2];
#pragma unroll
    for (int i = 0; i < 2; ++i) { int R, C; stage_rc(tid * 16 + i * 8192, R, C); const int Rb = Epi::PERM ? ((R & ~31) + perm32(R & 31)) : R;
        voffA[i] = (unsigned)(R * K + C) * 2u; voffB[i] = (unsigned)(Rb * K + C) * 2u; }
    const size_t kstep = (size_t)(BK * 2);
    const size_t hstep = (size_t)HALF * K * 2;
    const size_t tstep = 2 * hstep;
    const unsigned ldsw = (unsigned)wid * 1024u;
    const int aoff = lds_byte(wr * 64 + fr, fq * 8), boff = lds_byte(wc * 32 + fr, fq * 8);
#define PG8_SA(b, h) (((b) * 2 + (h)) * HTB)
#define PG8_SB(b, h) ((4 + (b) * 2 + (h)) * HTB)
#define PG8_STAGE(bufoff, gbase, voff) do { _Pragma("unroll") for (int _i = 0; _i < 2; ++_i) \
        __builtin_amdgcn_global_load_lds((const unsigned*)((const char*)(gbase) + (voff)[_i]), (PG8_LAS unsigned*)(lds + (bufoff) + ldsw + _i * 8192), 16, 0, 0); } while (0)
#define PG8_LDA(dst, b, h) do { _Pragma("unroll") for (int m = 0; m < 4; ++m) _Pragma("unroll") for (int k = 0; k < 2; ++k) dst[m][k] = *(const PG8_LAS bf16x8*)(lds + PG8_SA(b, h) + aoff + m * 2048 + k * 1024); } while (0)
#define PG8_LDB(dst, b, h) do { _Pragma("unroll") for (int n = 0; n < 2; ++n) _Pragma("unroll") for (int k = 0; k < 2; ++k) dst[n][k] = *(const PG8_LAS bf16x8*)(lds + PG8_SB(b, h) + boff + n * 2048 + k * 1024); } while (0)
#define PG8_MMA(ai, bj, At, Bt) do { __builtin_amdgcn_s_setprio(1); _Pragma("unroll") for (int m = 0; m < 4; ++m) _Pragma("unroll") for (int n = 0; n < 2; ++n) _Pragma("unroll") for (int k = 0; k < 2; ++k) \
        acc[ai][bj][m][n] = __builtin_amdgcn_mfma_f32_16x16x32_bf16(Bt[n][k], At[m][k], acc[ai][bj][m][n], 0, 0, 0); __builtin_amdgcn_s_setprio(0); } while (0)
#define PG8_WAIT_V(n) asm volatile("s_waitcnt vmcnt(" #n ")" ::: "memory")
#define PG8_WAIT_L(n) asm volatile("s_waitcnt lgkmcnt(" #n ")" ::: "memory")
#define PG8_BAR __builtin_amdgcn_s_barrier()
#define PG8_SCHED __builtin_amdgcn_sched_barrier(0)
    Unit cur, nxt; int ui = 0;
    if (!S.next(0, cur)) return;
    f32x4 acc[2][2][4][2];
#pragma unroll
    for (int a = 0; a < 2; ++a)
#pragma unroll
        for (int b = 0; b < 2; ++b)
#pragma unroll
            for (int m = 0; m < 4; ++m)
#pragma unroll
                for (int n = 0; n < 2; ++n) acc[a][b][m][n] = (f32x4){0.f, 0.f, 0.f, 0.f};
    bf16x8 At[4][2], B0[2][2], B1[2][2];
    const char* cA = (const char*)g.A + (size_t)cur.pm * tstep; const char* cB = (const char*)g.Bt + (size_t)cur.pn * tstep;
    S.a_ready(cur);
    if constexpr (SP2) {
        PG8_STAGE(PG8_SB(0, 0), cB, voffB); PG8_STAGE(PG8_SB(0, 1), cB + hstep, voffB); PG8_STAGE(PG8_SA(0, 0), cA, voffA); PG8_STAGE(PG8_SA(0, 1), cA + hstep, voffA);
        if (wr == 1) PG8_BAR;
        PG8_WAIT_V(2); PG8_BAR;
        PG8_STAGE(PG8_SB(1, 0), cB + kstep, voffB); PG8_STAGE(PG8_SA(1, 0), cA + kstep, voffA); PG8_STAGE(PG8_SB(1, 1), cB + hstep + kstep, voffB);
        PG8_WAIT_V(6); PG8_BAR;
    } else {
        PG8_STAGE(PG8_SB(0, 0), cB, voffB); PG8_STAGE(PG8_SA(0, 0), cA, voffA); PG8_STAGE(PG8_SB(0, 1), cB + hstep, voffB); PG8_STAGE(PG8_SA(0, 1), cA + hstep, voffA);
        if (wr == 1) PG8_BAR;
        PG8_WAIT_V(4); PG8_BAR;
        PG8_STAGE(PG8_SB(1, 0), cB + kstep, voffB); PG8_STAGE(PG8_SA(1, 0), cA + kstep, voffA); PG8_STAGE(PG8_SB(1, 1), cB + hstep + kstep, voffB);
        PG8_WAIT_V(6); PG8_BAR;
    }
    for (;;) {
        const bool has_next = S.next(ui + 1, nxt);
        const char* nA = has_next ? (const char*)g.A + (size_t)nxt.pm * tstep : cA; const char* nB = has_next ? (const char*)g.Bt + (size_t)nxt.pn * tstep : cB;
        for (int t = 0; t < nt; t += 2) {
            const bool last = (t == nt - 2);
            const char* a1 = cA + (size_t)(t + 1) * kstep;
            const char* a2 = last ? nA : cA + (size_t)(t + 2) * kstep; const char* b2 = last ? nB : cB + (size_t)(t + 2) * kstep;
            const char* a3 = a2 + kstep; const char* b3 = b2 + kstep;
            if (last && has_next) S.a_ready(nxt);
            if constexpr (SP2) {
            PG8_LDB(B0, 0, 0); PG8_LDB(B1, 0, 1); PG8_SCHED; PG8_LDA(At, 0, 0); PG8_STAGE(PG8_SA(1, 1), a1 + hstep, voffA);
            PG8_WAIT_V(8); PG8_WAIT_L(0); PG8_BAR; PG8_MMA(0, 0, At, B0); PG8_MMA(0, 1, At, B1); PG8_BAR; PG8_SCHED;
            PG8_LDA(At, 0, 1); PG8_STAGE(PG8_SB(0, 0), b2, voffB); PG8_STAGE(PG8_SB(0, 1), b2 + hstep, voffB); PG8_STAGE(PG8_SA(0, 0), a2, voffA);
            PG8_WAIT_V(8); PG8_WAIT_L(0); PG8_BAR; PG8_MMA(1, 0, At, B0); PG8_MMA(1, 1, At, B1); PG8_BAR; PG8_SCHED;
            PG8_LDB(B0, 1, 0); PG8_LDB(B1, 1, 1); PG8_SCHED; PG8_LDA(At, 1, 0); PG8_STAGE(PG8_SA(0, 1), a2 + hstep, voffA);
            PG8_WAIT_V(8); PG8_WAIT_L(0); PG8_BAR; PG8_MMA(0, 0, At, B0); PG8_MMA(0, 1, At, B1); PG8_BAR; PG8_SCHED;
            PG8_LDA(At, 1, 1); PG8_STAGE(PG8_SB(1, 0), b3, voffB); PG8_STAGE(PG8_SB(1, 1), b3 + hstep, voffB); PG8_STAGE(PG8_SA(1, 0), a3, voffA);
            PG8_WAIT_V(8); PG8_WAIT_L(0); PG8_BAR; PG8_MMA(1, 0, At, B0); PG8_MMA(1, 1, At, B1); PG8_BAR; PG8_SCHED;
            } else {
            PG8_LDB(B0, 0, 0); PG8_SCHED; PG8_LDA(At, 0, 0); PG8_STAGE(PG8_SA(1, 1), a1 + hstep, voffA);
            PG8_WAIT_L(8); PG8_BAR; PG8_WAIT_L(0); PG8_MMA(0, 0, At, B0); PG8_BAR; PG8_SCHED;
            PG8_LDB(B1, 0, 1); PG8_STAGE(PG8_SB(0, 0), b2, voffB);
            PG8_BAR; PG8_WAIT_L(0); PG8_MMA(0, 1, At, B1); PG8_BAR;
            PG8_LDA(At, 0, 1); PG8_STAGE(PG8_SA(0, 0), a2, voffA);
            PG8_BAR; PG8_WAIT_L(0); PG8_MMA(1, 0, At, B0); PG8_BAR; PG8_SCHED;
            PG8_STAGE(PG8_SB(0, 1), b2 + hstep, voffB);
            PG8_WAIT_V(6); PG8_BAR; PG8_MMA(1, 1, At, B1); PG8_BAR;
            PG8_LDB(B0, 1, 0); PG8_SCHED; PG8_LDA(At, 1, 0); PG8_STAGE(PG8_SA(0, 1), a2 + hstep, voffA);
            PG8_WAIT_L(8); PG8_BAR; PG8_WAIT_L(0); PG8_MMA(0, 0, At, B0); PG8_BAR; PG8_SCHED;
            PG8_LDB(B1, 1, 1); PG8_STAGE(PG8_SB(1, 0), b3, voffB);
            PG8_BAR; PG8_WAIT_L(0); PG8_MMA(0, 1, At, B1); PG8_BAR;
            PG8_LDA(At, 1, 1); PG8_STAGE(PG8_SA(1, 0), a3, voffA);
            PG8_BAR; PG8_WAIT_L(0); PG8_MMA(1, 0, At, B0); PG8_BAR; PG8_SCHED;
            PG8_STAGE(PG8_SB(1, 1), b3 + hstep, voffB);
            PG8_WAIT_V(6); PG8_BAR; PG8_MMA(1, 1, At, B1); PG8_BAR;
            }
        }
        if constexpr (ALIGN_EPI) { if (wr == 0) PG8_BAR; }
        if constexpr (!Epi::AFTER_DRAIN) { E(acc, cur, wr, wc, fr, fq); S.done(cur); }
        if (!has_next) break;
#pragma unroll
        for (int a = 0; a < 2; ++a)
#pragma unroll
            for (int b = 0; b < 2; ++b)
#pragma unroll
                for (int m = 0; m < 4; ++m)
#pragma unroll
                    for (int n = 0; n < 2; ++n) acc[a][b][m][n] = (f32x4){0.f, 0.f, 0.f, 0.f};
        cur = nxt; cA = nA; cB = nB; ++ui;
        if constexpr (ALIGN_EPI) { if (wr == 1) PG8_BAR; }
    }
    PG8_WAIT_V(0);
    if constexpr (!ALIGN_EPI) { if (wr == 0) PG8_BAR; }
    PG8_BAR;
    if constexpr (Epi::AFTER_DRAIN) { E.fused(acc, cur, wr, wc, fr, fq, lds, wid, lane); S.done(cur); }
#undef PG8_SA
#undef PG8_SB
#undef PG8_STAGE
#undef PG8_LDA
#undef PG8_LDB
#undef PG8_MMA
#undef PG8_WAIT_V
#undef PG8_WAIT_L
#undef PG8_BAR
#undef PG8_SCHED
}
}

#define LAS __attribute__((address_space(3)))
typedef pg8::bf16_t bf16_t;
typedef pg8::bf16x8 bf16x8;
typedef pg8::f32x4 f32x4;
typedef pg8::u32x4 u32x4;
typedef float f32x16 __attribute__((ext_vector_type(16)));
typedef float f32x2 __attribute__((ext_vector_type(2)));
typedef unsigned u32x2 __attribute__((ext_vector_type(2)));

constexpr int NB = 4, SEQ = 8192, DM = 1024, MTOK = NB * SEQ;
constexpr int DFF = 2816;
constexpr int NGRP = 32, NST = 64, GCH = 16, NCHK = SEQ / 64;
constexpr float LOG2E = 1.4426950408889634f;
constexpr float QSCALE = 0.125f * LOG2E;
constexpr float ALPHA = 1.4142135623730951f;
constexpr float LN_EPS = 1e-5f;

constexpr size_t MiB = 1u << 20;
constexpr size_t WS_S5P = 1 * MiB, WS_S5S = 2 * MiB, WS_S5X = 10 * MiB;
constexpr size_t WS_WQKU0 = 18 * MiB, WS_WV0 = 21 * MiB, WS_WGLU = 22 * MiB, WS_WOUT0 = 23 * MiB, WS_W13_0 = 25 * MiB, WS_W2_0 = 36 * MiB;
constexpr size_t WS_WQK1 = 42 * MiB, WS_WV1 = 46 * MiB, WS_WOUT1 = 48 * MiB, WS_W13_1 = 50 * MiB, WS_W2_1 = 61 * MiB;
constexpr size_t WS_HB = 68 * MiB, WS_PROJ = 132 * MiB, WS_VT = 260 * MiB, WS_HID = 132 * MiB, WS_MIX = 324 * MiB, WS_YG = 388 * MiB, WS_END = 420 * MiB;
constexpr size_t S5P_ABAR = 0, S5P_AL = 16384, S5P_BBAR = 65536, S5P_CMAT = 65536 + 262144, S5P_BIAS = S5P_CMAT + 131072;
constexpr int BIAS_LD = 260;

constexpr int LDS_CTL_OFF = 156672, LDS_BYTES = LDS_CTL_OFF + 1024;

__device__ __forceinline__ float bf2f(unsigned short h) { return __uint_as_float(((unsigned)h) << 16); }
__device__ __forceinline__ unsigned pk2(float lo, float hi) { return pg8::cvt_pk_bf16(lo, hi); }
__device__ __forceinline__ float fast_exp2(float x) { return __builtin_amdgcn_exp2f(x); }
__device__ __forceinline__ float fast_log2(float x) { return __builtin_amdgcn_logf(x); }
__device__ __forceinline__ float fast_rcp(float x) { return __builtin_amdgcn_rcpf(x); }
__device__ __forceinline__ float sigmoidf_(float v) { return fast_rcp(1.0f + fast_exp2(-v * LOG2E)); }

struct EpiStoreBf16 {
    static constexpr bool PERM = true, AFTER_DRAIN = false;
    bf16_t* O; int ldc; int scale_cols; float scale0;
    __device__ __forceinline__ void operator()(const f32x4 (&acc)[2][2][4][2], const pg8::Unit& u, int wr, int wc, int fr, int fq) const {
        const int row0 = u.pm * 256 + wr * 64 + fr, col0 = u.pn * 256 + wc * 32 + 8 * fq;
        const float sc = (u.pn * 256 < scale_cols) ? scale0 : 1.0f;
#pragma unroll
        for (int ai = 0; ai < 2; ++ai)
#pragma unroll
            for (int m = 0; m < 4; ++m) { bf16_t* rowp = O + (size_t)(row0 + ai * 128 + m * 16) * ldc + col0;
#pragma unroll
                for (int bj = 0; bj < 2; ++bj) { const f32x4 v0 = acc[ai][bj][m][0] * sc, v1 = acc[ai][bj][m][1] * sc; u32x4 w;
                    w.x = pk2(v0[0], v0[1]); w.y = pk2(v0[2], v0[3]); w.z = pk2(v1[0], v1[1]); w.w = pk2(v1[2], v1[3]);
                    *(u32x4*)(rowp + bj * 128) = w; } }
    }
};
struct EpiSwiglu {
    static constexpr bool PERM = true, AFTER_DRAIN = false;
    bf16_t* O; int ldc;
    __device__ __forceinline__ void operator()(const f32x4 (&acc)[2][2][4][2], const pg8::Unit& u, int wr, int wc, int fr, int fq) const {
        const int row0 = u.pm * 256 + wr * 64 + fr, col0 = u.pn * 128 + wc * 32 + 8 * fq;
#pragma unroll
        for (int ai = 0; ai < 2; ++ai)
#pragma unroll
            for (int m = 0; m < 4; ++m) { bf16_t* rowp = O + (size_t)(row0 + ai * 128 + m * 16) * ldc + col0; float h[8];
#pragma unroll
                for (int n = 0; n < 2; ++n)
#pragma unroll
                    for (int e = 0; e < 4; ++e) { const float a = acc[ai][0][m][n][e], b = acc[ai][1][m][n][e]; h[n * 4 + e] = a * sigmoidf_(a) * b; }
                u32x4 w; w.x = pk2(h[0], h[1]); w.y = pk2(h[2], h[3]); w.z = pk2(h[4], h[5]); w.w = pk2(h[6], h[7]);
                *(u32x4*)rowp = w; }
    }
};
struct EpiResF32 {
    static constexpr bool PERM = false, AFTER_DRAIN = false;
    const float* res; float* out; float alpha;
    __device__ __forceinline__ void operator()(const f32x4 (&acc)[2][2][4][2], const pg8::Unit& u, int wr, int wc, int fr, int fq) const {
        const int col0 = u.pn * 256 + wc * 32 + 4 * fq;
#pragma unroll
        for (int ai = 0; ai < 2; ++ai)
#pragma unroll
            for (int m = 0; m < 4; ++m) { const size_t off = (size_t)(u.pm * 256 + ai * 128 + wr * 64 + m * 16 + fr) * DM + col0;
#pragma unroll
                for (int bj = 0; bj < 2; ++bj)
#pragma unroll
                    for (int n = 0; n < 2; ++n) { const f32x4 rs = *(const f32x4*)(res + off + bj * 128 + n * 16); *(f32x4*)(out + off + bj * 128 + n * 16) = rs * alpha + acc[ai][bj][m][n]; } }
    }
};
struct EpiGlu {
    static constexpr bool PERM = true, AFTER_DRAIN = false;
    const bf16_t* YG; const float* bias; bf16_t* O;
    __device__ __forceinline__ void operator()(const f32x4 (&acc)[2][2][4][2], const pg8::Unit& u, int wr, int wc, int fr, int fq) const {
        const int row0 = u.pm * 256 + wr * 64 + fr, col0 = u.pn * 256 + wc * 32 + 8 * fq;
#pragma unroll
        for (int ai = 0; ai < 2; ++ai)
#pragma unroll
            for (int m = 0; m < 4; ++m) { const size_t row = (size_t)(row0 + ai * 128 + m * 16);
#pragma unroll
                for (int bj = 0; bj < 2; ++bj) { const int c = col0 + bj * 128;
                    const u32x4 y = *(const u32x4*)(YG + row * 512 + c); const f32x4 b0 = *(const f32x4*)(bias + c), b1 = *(const f32x4*)(bias + c + 4);
                    const f32x4 v0 = acc[ai][bj][m][0] + b0, v1 = acc[ai][bj][m][1] + b1; float o[8];
                    o[0] = bf2f(y.x & 0xffff) * sigmoidf_(v0[0]); o[1] = bf2f(y.x >> 16) * sigmoidf_(v0[1]); o[2] = bf2f(y.y & 0xffff) * sigmoidf_(v0[2]); o[3] = bf2f(y.y >> 16) * sigmoidf_(v0[3]);
                    o[4] = bf2f(y.z & 0xffff) * sigmoidf_(v1[0]); o[5] = bf2f(y.z >> 16) * sigmoidf_(v1[1]); o[6] = bf2f(y.w & 0xffff) * sigmoidf_(v1[2]); o[7] = bf2f(y.w >> 16) * sigmoidf_(v1[3]);
                    u32x4 w; w.x = pk2(o[0], o[1]); w.y = pk2(o[2], o[3]); w.z = pk2(o[4], o[5]); w.w = pk2(o[6], o[7]);
                    *(u32x4*)(O + row * DM + 512 + c) = w; } }
    }
};

__device__ __forceinline__ void transpose_item(const float* W, int ldw, int K, bf16_t* WT, int dst_row0, LAS float* scr, int k0, int n0, int lane) {
#pragma unroll 8
    for (int i = 0; i < 32; ++i) { const int kk = 2 * i + (lane >> 5); scr[kk * 33 + (lane & 31)] = W[(size_t)(k0 + kk) * ldw + n0 + (lane & 31)]; }
    asm volatile("s_waitcnt lgkmcnt(0)" ::: "memory");
    const int c = lane & 7;
#pragma unroll
    for (int j = 0; j < 4; ++j) { const int n = (lane >> 3) + 8 * j; const LAS float* s = scr + (8 * c) * 33 + n;
        u32x4 o; o.x = pk2(s[0 * 33], s[1 * 33]); o.y = pk2(s[2 * 33], s[3 * 33]); o.z = pk2(s[4 * 33], s[5 * 33]); o.w = pk2(s[6 * 33], s[7 * 33]);
        *(u32x4*)(WT + (size_t)(dst_row0 + n) * K + k0 + 8 * c) = o; }
    asm volatile("s_waitcnt lgkmcnt(0)" ::: "memory");
}
__device__ __forceinline__ void transpose_matrix(const float* W, int ldw, int K, int ncols, bf16_t* WT, int row_off, int mode, LAS float* scr, int gw, int ngw, int lane) {
    const int nblk = ncols / 32, nitems = (K / 64) * nblk;
    for (int it = gw; it < nitems; it += ngw) { const int kb = it / nblk, nb = it % nblk, n0 = 32 * nb;
        const int dr = (mode == 0) ? (row_off + n0) : ((n0 >> 7) * 256 + (mode == 2 ? 128 : 0) + (n0 & 127));
        transpose_item(W, ldw, K, WT, dr, scr, 64 * kb, n0, lane); }
}
__device__ __forceinline__ void sincos_f(float x, float& s, float& c) {
    const float k = rintf(x * 0.63661977236758134f);
    float r = fmaf(-k, 1.5707962513e+00f, x); r = fmaf(-k, 7.5497894159e-08f, r); r = fmaf(-k, 5.3903029534e-15f, r);
    const float r2 = r * r;
    const float sp = r + r * r2 * (-1.6666654611e-1f + r2 * (8.3321608736e-3f + r2 * (-1.9515295891e-4f)));
    const float cp = 1.0f - 0.5f * r2 + r2 * r2 * (4.166664568298827e-2f + r2 * (-1.388731625493765e-3f + r2 * 2.443315711809948e-5f));
    const int q = ((int)k) & 3;
    s = (q == 0) ? sp : (q == 1) ? cp : (q == 2) ? -sp : -cp;
    c = (q == 0) ? cp : (q == 1) ? -sp : (q == 2) ? -cp : sp;
}

#define XB_TMO      128
#define XB_XCNT(j)  (256  + 64 * (j))
#define XB_XSUB(j)  (1280 + 64 * (j))
#define XB_XGEN(j)  (2304 + 64 * (j))
#define XB_TOP      3328
#define XB_TOPGEN   3392
#define XCD_BAR_WORDS 3456
#define XB_SPIN_CAP (1u << 18)

__device__ __forceinline__ unsigned xb_ld(unsigned* p)              { return __hip_atomic_load(p, __ATOMIC_RELAXED, __HIP_MEMORY_SCOPE_AGENT); }
__device__ __forceinline__ unsigned xb_add(unsigned* p, unsigned v) { return __hip_atomic_fetch_add(p, v, __ATOMIC_RELAXED, __HIP_MEMORY_SCOPE_AGENT); }
__device__ __forceinline__ unsigned xb_xcc_id() { return (unsigned)__builtin_amdgcn_s_getreg((3 << 11) | 20) & 0xFu; }
#define XB_SPIN(cond, bar) do { unsigned _sp = 0; while (cond) { __builtin_amdgcn_s_sleep(1); \
    if ((++_sp & 255u) == 0u) { if (xb_ld(&(bar)[XB_TMO])) break; if (_sp > XB_SPIN_CAP) { atomicAdd(&(bar)[XB_TMO], 1u); break; } } } } while (0)

struct XcdBarrier {
    unsigned* bar; unsigned x;
    volatile LAS unsigned* st;
};

__device__ __forceinline__ XcdBarrier xcd_barrier_post(unsigned* bar, volatile LAS unsigned* st) {
    XcdBarrier b; b.bar = bar; b.x = xb_xcc_id(); b.st = st;
    if (threadIdx.x == 0) (void)xb_add(&bar[XB_XCNT(b.x)], 1u);
    return b;
}
__device__ __forceinline__ void xcd_barrier_complete(unsigned* bar, unsigned x, unsigned& nloc, unsigned& nx) {
    const unsigned G = gridDim.x * gridDim.y * gridDim.z;
    unsigned sum, cnt, mine, sp = 0u;
    for (;;) {
        sum = 0u; cnt = 0u; mine = 0u;
#pragma unroll
        for (unsigned j = 0; j < 16; ++j) { const unsigned c = xb_ld(&bar[XB_XCNT(j)]); sum += c; cnt += (c > 0u) ? 1u : 0u; mine = (j == x) ? c : mine; }
        if (sum == G) break;
        __builtin_amdgcn_s_sleep(1);
        if ((++sp & 255u) == 0u) { if (xb_ld(&bar[XB_TMO])) break; if (sp > XB_SPIN_CAP) { atomicAdd(&bar[XB_TMO], 1u); break; } }
    }
    nloc = mine > 0u ? mine : 1u; nx = cnt > 0u ? cnt : 1u;
}

__device__ __forceinline__ void xcd_barrier(const XcdBarrier& b) {
    asm volatile("s_waitcnt vmcnt(0)" ::: "memory");
    __syncthreads();
    if (threadIdx.x == 0) {
        unsigned* bar = b.bar;
        __builtin_amdgcn_s_waitcnt(0);
        unsigned nloc = b.st[0], nx = b.st[1];
        if (nloc == 0u) { xcd_barrier_complete(bar, b.x, nloc, nx); b.st[0] = nloc; b.st[1] = nx; }
        const unsigned old = xb_add(&bar[XB_XSUB(b.x)], 1u);
        const unsigned gen = old / nloc;
        if (old + 1u == (gen + 1u) * nloc) {
            __builtin_amdgcn_fence(__ATOMIC_RELEASE, "agent");
            asm volatile("s_waitcnt vmcnt(0)" ::: "memory");
            const unsigned og = xb_add(&bar[XB_TOP], 1u);
            const unsigned tg = og / nx;
            if (og + 1u == (tg + 1u) * nx) xb_add(&bar[XB_TOPGEN], 1u);
            else XB_SPIN(xb_ld(&bar[XB_TOPGEN]) == tg, bar);
            __builtin_amdgcn_fence(__ATOMIC_ACQUIRE, "agent");
            xb_add(&bar[XB_XGEN(b.x)], 1u);
            asm volatile("s_waitcnt vmcnt(0)" ::: "memory");
        } else {
            XB_SPIN(xb_ld(&bar[XB_XGEN(b.x)]) == gen, bar);
            __builtin_amdgcn_fence(__ATOMIC_ACQUIRE, "agent");
            asm volatile("s_waitcnt vmcnt(0)" ::: "memory");
        }
    }
    __syncthreads();
}

struct Ctx {
    const float* in[23]; float* out; unsigned char* ws;
    LAS unsigned char* lds;
};
struct Ids { int tid, lane, wave, gw, ngw; };
__device__ __forceinline__ Ids phase_ids() { Ids I; int t = threadIdx.x; asm volatile("" : "+v"(t)); I.tid = t; I.lane = t & 63; I.wave = __builtin_amdgcn_readfirstlane(t >> 6); I.gw = (int)blockIdx.x * 8 + I.wave; I.ngw = (int)gridDim.x * 8; return I; }
template <class T> __device__ __forceinline__ T* wsp(const Ctx& C, size_t off) { return (T*)(C.ws + off); }

__device__ __forceinline__ void phase_prologue(const Ctx& C) {
    const Ids I = phase_ids();
    LAS float* scr = (LAS float*)(C.lds + I.wave * 16384);
    const int gw = I.gw, ngw = I.ngw, lane = I.lane;
    const float* win0 = C.in[1]; const float* win1 = C.in[14];
    transpose_matrix(win0, 2048, 1024, 1024, wsp<bf16_t>(C, WS_WQKU0), 0, 0, scr, gw, ngw, lane);
    transpose_matrix(win0 + 1536, 2048, 1024, 512, wsp<bf16_t>(C, WS_WQKU0), 1024, 0, scr, gw, ngw, lane);
    transpose_matrix(win0 + 1024, 2048, 1024, 512, wsp<bf16_t>(C, WS_WV0), 0, 0, scr, gw, ngw, lane);
    transpose_matrix(C.in[11], 512, 512, 512, wsp<bf16_t>(C, WS_WGLU), 0, 0, scr, gw, ngw, lane);
    transpose_matrix(C.in[13], 1024, 1024, 1024, wsp<bf16_t>(C, WS_WOUT0), 0, 0, scr, gw, ngw, lane);
    transpose_matrix(win1, 3072, 1024, 2048, wsp<bf16_t>(C, WS_WQK1), 0, 0, scr, gw, ngw, lane);
    transpose_matrix(win1 + 2048, 3072, 1024, 1024, wsp<bf16_t>(C, WS_WV1), 0, 0, scr, gw, ngw, lane);
    transpose_matrix(C.in[15], 1024, 1024, 1024, wsp<bf16_t>(C, WS_WOUT1), 0, 0, scr, gw, ngw, lane);
#pragma unroll 1
    for (int l = 0; l < 2; ++l) {
        transpose_matrix(C.in[16] + (size_t)l * DM * DFF, DFF, 1024, DFF, wsp<bf16_t>(C, l ? WS_W13_1 : WS_W13_0), 0, 1, scr, gw, ngw, lane);
        transpose_matrix(C.in[17] + (size_t)l * DM * DFF, DFF, 1024, DFF, wsp<bf16_t>(C, l ? WS_W13_1 : WS_W13_0), 0, 2, scr, gw, ngw, lane);
        transpose_matrix(C.in[18] + (size_t)l * DM * DFF, 1024, DFF, 1024, wsp<bf16_t>(C, l ? WS_W2_1 : WS_W2_0), 0, 0, scr, gw, ngw, lane);
    }
    { const float* x = C.in[0]; bf16_t* xb = wsp<bf16_t>(C, WS_HB); const size_t n8 = (size_t)MTOK * DM / 8, gt = (size_t)blockIdx.x * 512 + I.tid, nt = (size_t)gridDim.x * 512;
      for (size_t i = gt; i < n8; i += nt) { const f32x4 a = *(const f32x4*)(x + i * 8), b = *(const f32x4*)(x + i * 8 + 4); u32x4 w; w.x = pk2(a[0], a[1]); w.y = pk2(a[2], a[3]); w.z = pk2(b[0], b[1]); w.w = pk2(b[2], b[3]); *(u32x4*)(xb + i * 8) = w; } }
    { const int gt = blockIdx.x * 512 + I.tid;
      if (gt < NGRP * NST) { const int g = gt / NST, p = gt % NST;
        const float dt = expf(C.in[10][g]); const float lr = C.in[3][gt], li = C.in[4][gt];
        const float a = lr * dt, b = li * dt; float sb, cb, sh, ch; sincos_f(b, sb, cb); sincos_f(0.5f * b, sh, ch);
        const float mag = expf(a), em1 = expm1f(a);
        const float ar = mag * cb, ai = mag * sb, ar1 = em1 * cb - 2.0f * sh * sh;
        const float den = lr * lr + li * li; const float fr = (ar1 * lr + ai * li) / den, fi = (ai * lr - ar1 * li) / den;
        f32x2* abar = wsp<f32x2>(C, WS_S5P + S5P_ABAR); f32x2* al = wsp<f32x2>(C, WS_S5P + S5P_AL); abar[gt] = (f32x2){ar, ai};
        float pr = ar, pi = ai;
#pragma unroll
        for (int s = 0; s < 6; ++s) { const float nr = pr * pr - pi * pi, ni = 2.0f * pr * pi; pr = nr; pi = ni; }
        al[gt] = (f32x2){pr, pi};
        f32x2* bbar = wsp<f32x2>(C, WS_S5P + S5P_BBAR) + (size_t)gt * GCH; const float* bre = C.in[5] + (size_t)gt * GCH; const float* bim = C.in[6] + (size_t)gt * GCH;
#pragma unroll
        for (int i = 0; i < GCH; ++i) bbar[i] = (f32x2){fr * bre[i] - fi * bim[i], fr * bim[i] + fi * bre[i]};
        bf16_t* cm = wsp<bf16_t>(C, WS_S5P + S5P_CMAT) + (size_t)g * GCH * 128; const float* cre = C.in[7] + (size_t)g * GCH * NST; const float* cim = C.in[8] + (size_t)g * GCH * NST;
#pragma unroll
        for (int i = 0; i < GCH; ++i) { cm[i * 128 + p] = (bf16_t)(pk2(cre[i * NST + p], 0.f) & 0xffff); cm[i * 128 + 64 + p] = (bf16_t)(pk2(-cim[i * NST + p], 0.f) & 0xffff); } }
      if (gt < 8 * 257) { const int h = gt / 257, i = gt % 257; wsp<float>(C, WS_S5P + S5P_BIAS)[h * BIAS_LD + i] = C.in[2][gt] * LOG2E; } }
}

__device__ __forceinline__ void phase_ln(const Ctx& C, float* buf, bf16_t* hb, const float* g, const float* b) {
    const Ids I = phase_ids();
    f32x4 gv[4], bv[4];
#pragma unroll
    for (int j = 0; j < 4; ++j) { gv[j] = *(const f32x4*)(g + 4 * I.lane + 256 * j); bv[j] = *(const f32x4*)(b + 4 * I.lane + 256 * j); }
    for (int m = I.gw; m < MTOK; m += I.ngw) {
        float* row = buf + (size_t)m * DM + 4 * I.lane; f32x4 v[4]; float s = 0.f;
#pragma unroll
        for (int j = 0; j < 4; ++j) { v[j] = *(const f32x4*)(row + 256 * j); s += (v[j][0] + v[j][1]) + (v[j][2] + v[j][3]); }
#pragma unroll
        for (int o = 1; o < 64; o <<= 1) s += __shfl_xor(s, o);
        const float mean = s * (1.0f / DM); float q = 0.f;
#pragma unroll
        for (int j = 0; j < 4; ++j) { v[j] = v[j] - mean; q += (v[j][0] * v[j][0] + v[j][1] * v[j][1]) + (v[j][2] * v[j][2] + v[j][3] * v[j][3]); }
#pragma unroll
        for (int o = 1; o < 64; o <<= 1) q += __shfl_xor(q, o);
        const float rstd = 1.0f / sqrtf(q * (1.0f / DM) + LN_EPS);
        bf16_t* hrow = hb + (size_t)m * DM + 4 * I.lane;
#pragma unroll
        for (int j = 0; j < 4; ++j) { const f32x4 y = v[j] * rstd * gv[j] + bv[j]; *(f32x4*)(row + 256 * j) = y; u32x2 w; w.x = pk2(y[0], y[1]); w.y = pk2(y[2], y[3]); *(u32x2*)(hrow + 256 * j) = w; }
    }
}

constexpr int S5_WAVE_LDS = 4096 + 8704, S5_XLD = 136;
__device__ __forceinline__ void s5_load_u(const Ctx& C, const Ids& I, LAS float* ut, const bf16_t* proj, int b, int g, int c) {
    const bf16_t* up = proj + (size_t)(b * SEQ + c * 64 + I.lane) * 1536 + 1024 + g * GCH;
    const u32x4 a = *(const u32x4*)up, d = *(const u32x4*)(up + 8);
    LAS f32x4* dst = (LAS f32x4*)(ut + I.lane * 16);
    dst[0] = (f32x4){bf2f(a.x & 0xffff), bf2f(a.x >> 16), bf2f(a.y & 0xffff), bf2f(a.y >> 16)}; dst[1] = (f32x4){bf2f(a.z & 0xffff), bf2f(a.z >> 16), bf2f(a.w & 0xffff), bf2f(a.w >> 16)};
    dst[2] = (f32x4){bf2f(d.x & 0xffff), bf2f(d.x >> 16), bf2f(d.y & 0xffff), bf2f(d.y >> 16)}; dst[3] = (f32x4){bf2f(d.z & 0xffff), bf2f(d.z >> 16), bf2f(d.w & 0xffff), bf2f(d.w >> 16)};
    asm volatile("s_waitcnt lgkmcnt(0)" ::: "memory");
}
#define S5_STEP(t) do { const LAS f32x4* ur = (const LAS f32x4*)(ut + (t) * 16); const f32x4 u0 = ur[0], u1 = ur[1], u2 = ur[2], u3 = ur[3]; \
    f32x2 bu = bb[0] * u0[0]; bu += bb[1] * u0[1]; bu += bb[2] * u0[2]; bu += bb[3] * u0[3]; bu += bb[4] * u1[0]; bu += bb[5] * u1[1]; bu += bb[6] * u1[2]; bu += bb[7] * u1[3]; \
    bu += bb[8] * u2[0]; bu += bb[9] * u2[1]; bu += bb[10] * u2[2]; bu += bb[11] * u2[3]; bu += bb[12] * u3[0]; bu += bb[13] * u3[1]; bu += bb[14] * u3[2]; bu += bb[15] * u3[3]; \
    const float nr = A.x * xr - A.y * xi + bu.x, ni = A.x * xi + A.y * xr + bu.y; xr = nr; xi = ni; } while (0)

__device__ __forceinline__ void phase_s5a(const Ctx& C) {
    const Ids I = phase_ids();
    LAS float* ut = (LAS float*)(C.lds + I.wave * S5_WAVE_LDS);
    const bf16_t* proj = wsp<bf16_t>(C, WS_PROJ); f32x2* S = wsp<f32x2>(C, WS_S5S);
    for (int it = I.gw; it < NB * NGRP * NCHK; it += I.ngw) {
        const int c = it % NCHK, g = (it / NCHK) % NGRP, b = it / (NCHK * NGRP);
        const f32x2 A = wsp<f32x2>(C, WS_S5P + S5P_ABAR)[g * NST + I.lane];
        f32x2 bb[16]; { const f32x4* bp = (const f32x4*)(wsp<f32x2>(C, WS_S5P + S5P_BBAR) + (size_t)(g * NST + I.lane) * GCH);
#pragma unroll
            for (int i = 0; i < 8; ++i) { const f32x4 t = bp[i]; bb[2 * i] = (f32x2){t[0], t[1]}; bb[2 * i + 1] = (f32x2){t[2], t[3]}; } }
        s5_load_u(C, I, ut, proj, b, g, c);
        float xr = 0.f, xi = 0.f;
#pragma unroll 4
        for (int t = 0; t < 64; ++t) S5_STEP(t);
        S[(size_t)it * NST + I.lane] = (f32x2){xr, xi};
        asm volatile("s_waitcnt lgkmcnt(0)" ::: "memory");
    }
}
__device__ __forceinline__ void phase_s5b(const Ctx& C) {
    const Ids I = phase_ids();
    const f32x2* S = wsp<f32x2>(C, WS_S5S); f32x2* X = wsp<f32x2>(C, WS_S5X);
    for (int it = I.gw; it < NB * NGRP; it += I.ngw) {
        const int g = it % NGRP; const f32x2 AL = wsp<f32x2>(C, WS_S5P + S5P_AL)[g * NST + I.lane];
        float xr = 0.f, xi = 0.f; const size_t base = (size_t)it * NCHK * NST + I.lane;
#pragma unroll 1
        for (int c0 = 0; c0 < NCHK; c0 += 16) { f32x2 s[16];
#pragma unroll
            for (int j = 0; j < 16; ++j) s[j] = S[base + (size_t)(c0 + j) * NST];
#pragma unroll
            for (int j = 0; j < 16; ++j) { X[base + (size_t)(c0 + j) * NST] = (f32x2){xr, xi}; const float nr = AL.x * xr - AL.y * xi + s[j].x, ni = AL.x * xi + AL.y * xr + s[j].y; xr = nr; xi = ni; } }
    }
}
__device__ __forceinline__ void phase_s5c(const Ctx& C) {
    const Ids I = phase_ids();
    LAS float* ut = (LAS float*)(C.lds + I.wave * S5_WAVE_LDS); LAS bf16_t* xt = (LAS bf16_t*)(C.lds + I.wave * S5_WAVE_LDS + 4096);
    const bf16_t* proj = wsp<bf16_t>(C, WS_PROJ); const f32x2* Xin = wsp<f32x2>(C, WS_S5X); bf16_t* YG = wsp<bf16_t>(C, WS_YG);
    const int l16 = I.lane & 15, kq = I.lane >> 4;
    for (int it = I.gw; it < NB * NGRP * NCHK; it += I.ngw) {
        const int c = it % NCHK, g = (it / NCHK) % NGRP, b = it / (NCHK * NGRP);
        const f32x2 A = wsp<f32x2>(C, WS_S5P + S5P_ABAR)[g * NST + I.lane];
        f32x2 bb[16]; { const f32x4* bp = (const f32x4*)(wsp<f32x2>(C, WS_S5P + S5P_BBAR) + (size_t)(g * NST + I.lane) * GCH);
#pragma unroll
            for (int i = 0; i < 8; ++i) { const f32x4 t = bp[i]; bb[2 * i] = (f32x2){t[0], t[1]}; bb[2 * i + 1] = (f32x2){t[2], t[3]}; } }
        bf16x8 cf[4]; { const bf16_t* cm = wsp<bf16_t>(C, WS_S5P + S5P_CMAT) + (size_t)(g * GCH + l16) * 128 + 8 * kq;
#pragma unroll
            for (int ks = 0; ks < 4; ++ks) cf[ks] = *(const bf16x8*)(cm + ks * 32); }
        const f32x4 dsk = *(const f32x4*)(C.in[9] + g * GCH + 4 * kq);
        s5_load_u(C, I, ut, proj, b, g, c);
        const f32x2 x0 = Xin[(size_t)it * NST + I.lane]; float xr = x0.x, xi = x0.y;
#pragma unroll 1
        for (int half = 0; half < 2; ++half) {
#pragma unroll 4
            for (int tt = 0; tt < 32; ++tt) { S5_STEP(half * 32 + tt);
                const unsigned w = pk2(xr, xi); xt[tt * S5_XLD + I.lane] = (bf16_t)(w & 0xffff); xt[tt * S5_XLD + 64 + I.lane] = (bf16_t)(w >> 16); }
            asm volatile("s_waitcnt lgkmcnt(0)" ::: "memory");
#pragma unroll
            for (int tb = 0; tb < 2; ++tb) { f32x4 acc = {0.f, 0.f, 0.f, 0.f};
#pragma unroll
                for (int ks = 0; ks < 4; ++ks) { const bf16x8 xf = *(const LAS bf16x8*)(xt + (tb * 16 + l16) * S5_XLD + ks * 32 + 8 * kq); acc = __builtin_amdgcn_mfma_f32_16x16x32_bf16(cf[ks], xf, acc, 0, 0, 0); }
                const int t = half * 32 + tb * 16 + l16; const f32x4 uu = *(const LAS f32x4*)(ut + t * 16 + 4 * kq);
                float y[4];
#pragma unroll
                for (int e = 0; e < 4; ++e) { const float v = acc[e] + dsk[e] * uu[e]; const float z = 1.5957691216057308f * (v + 0.044715f * v * v * v); y[e] = v * fast_rcp(1.0f + fast_exp2(-z * LOG2E)); }
                u32x2 w; w.x = pk2(y[0], y[1]); w.y = pk2(y[2], y[3]);
                *(u32x2*)(YG + (size_t)(b * SEQ + c * 64 + t) * 512 + g * GCH + 4 * kq) = w; }
            asm volatile("s_waitcnt lgkmcnt(0)" ::: "memory");
        }
    }
}

__device__ __forceinline__ int crow(int r, int hi) { return (r & 3) + 8 * (r >> 2) + 4 * hi; }
__device__ __forceinline__ f32x16 qk32(const bf16_t* kp, const bf16x8 (&qr)[4]) {
    f32x16 p = {0.f, 0.f, 0.f, 0.f, 0.f, 0.f, 0.f, 0.f, 0.f, 0.f, 0.f, 0.f, 0.f, 0.f, 0.f, 0.f};
#pragma unroll
    for (int d0 = 0; d0 < 4; ++d0) { const bf16x8 kf = *(const bf16x8*)(kp + d0 * 16); p = __builtin_amdgcn_mfma_f32_32x32x16_bf16(kf, qr[d0], p, 0, 0, 0); }
    return p;
}
__device__ __forceinline__ bf16x8 pack8(const f32x16& p, int s) {
    u32x4 w; w.x = pk2(p[8 * s + 0], p[8 * s + 1]); w.y = pk2(p[8 * s + 2], p[8 * s + 3]); w.z = pk2(p[8 * s + 4], p[8 * s + 5]); w.w = pk2(p[8 * s + 6], p[8 * s + 7]);
    return __builtin_bit_cast(bf16x8, w);
}
__device__ __forceinline__ void pv64(f32x16 (&o)[2], const bf16_t* vt, size_t vstride32, const f32x16& p0, const f32x16& p1) {
#pragma unroll
    for (int ks = 0; ks < 4; ++ks) { const bf16x8 pb = (ks < 2) ? pack8(p0, ks & 1) : pack8(p1, ks & 1);
#pragma unroll
        for (int db = 0; db < 2; ++db) { const bf16_t* vp = vt + db * vstride32 + 32 * (ks >> 1) + 16 * (ks & 1);
            const u32x2 lo = *(const u32x2*)vp, hi = *(const u32x2*)(vp + 8); const u32x4 w = {lo.x, lo.y, hi.x, hi.y};
            o[db] = __builtin_amdgcn_mfma_f32_32x32x16_bf16(__builtin_bit_cast(bf16x8, w), pb, o[db], 0, 0, 0); } }
}
__device__ __forceinline__ void store_ot(bf16_t* orow, const f32x16 (&o)[2], float sc, int hi) {
#pragma unroll
    for (int db = 0; db < 2; ++db)
#pragma unroll
        for (int a = 0; a < 4; ++a) { u32x2 w; w.x = pk2(o[db][4 * a] * sc, o[db][4 * a + 1] * sc); w.y = pk2(o[db][4 * a + 2] * sc, o[db][4 * a + 3] * sc); *(u32x2*)(orow + db * 32 + 8 * a + 4 * hi) = w; }
}
__device__ __forceinline__ float half_lo(float v, float& up) { auto rr = __builtin_amdgcn_permlane32_swap(__float_as_uint(v), __float_as_uint(v), false, false); up = __uint_as_float(rr[1]); return __uint_as_float(rr[0]); }

constexpr int AT_ROWB = 144, AT_HEADB = 2 * 64 * AT_ROWB, AT_STAGEB = 4 * AT_HEADB, AT_BIAS_OFF = 2 * AT_STAGEB;
struct AtStage { u32x4 k[4], v[4]; };
__device__ __forceinline__ void at_load(AtStage& R, const bf16_t* kbase, int ldk, const bf16_t* vbase, int tid) {
#pragma unroll
    for (int i = 0; i < 4; ++i) { const int idx = tid + 512 * i, row = idx >> 5, c16 = idx & 31; R.k[i] = *(const u32x4*)(kbase + (size_t)row * ldk + c16 * 8); }
#pragma unroll
    for (int i = 0; i < 4; ++i) { const int idx = tid + 512 * i, vrow = idx >> 3, c16 = idx & 7; R.v[i] = *(const u32x4*)(vbase + (size_t)vrow * MTOK + c16 * 8); }
}
__device__ __forceinline__ void at_store(const AtStage& R, LAS unsigned char* st, int tid) {
#pragma unroll
    for (int i = 0; i < 4; ++i) { const int idx = tid + 512 * i, row = idx >> 5, c16 = idx & 31; *(LAS u32x4*)(st + (c16 >> 3) * AT_HEADB + row * AT_ROWB + (c16 & 7) * 16) = R.k[i]; }
#pragma unroll
    for (int i = 0; i < 4; ++i) { const int idx = tid + 512 * i, vrow = idx >> 3, c16 = idx & 7; *(LAS u32x4*)(st + (vrow >> 6) * AT_HEADB + 9216 + (vrow & 63) * AT_ROWB + c16 * 16) = R.v[i]; }
}
__device__ __forceinline__ f32x16 qk32_lds(const LAS unsigned char* kp, const bf16x8 (&qr)[4]) {
    f32x16 p = {0.f, 0.f, 0.f, 0.f, 0.f, 0.f, 0.f, 0.f, 0.f, 0.f, 0.f, 0.f, 0.f, 0.f, 0.f, 0.f};
#pragma unroll
    for (int d0 = 0; d0 < 4; ++d0) { const bf16x8 kf = *(const LAS bf16x8*)(kp + d0 * 32); p = __builtin_amdgcn_mfma_f32_32x32x16_bf16(kf, qr[d0], p, 0, 0, 0); }
    return p;
}
__device__ __forceinline__ void pv64_lds(f32x16 (&o)[2], const LAS unsigned char* vp, const f32x16& p0, const f32x16& p1) {
#pragma unroll
    for (int ks = 0; ks < 4; ++ks) { const bf16x8 pb = (ks < 2) ? pack8(p0, ks & 1) : pack8(p1, ks & 1);
#pragma unroll
        for (int db = 0; db < 2; ++db) { const LAS unsigned char* a = vp + db * 32 * AT_ROWB + 64 * (ks >> 1) + 32 * (ks & 1);
            const u32x2 lo = *(const LAS u32x2*)a, hi = *(const LAS u32x2*)(a + 16); const u32x4 w = {lo.x, lo.y, hi.x, hi.y};
            o[db] = __builtin_amdgcn_mfma_f32_32x32x16_bf16(__builtin_bit_cast(bf16x8, w), pb, o[db], 0, 0, 0); } }
}

__device__ __forceinline__ void phase_chunk_attn(const Ctx& C) {
    const Ids I = phase_ids();
    const bf16_t* proj = wsp<bf16_t>(C, WS_PROJ); const bf16_t* VT = wsp<bf16_t>(C, WS_VT); bf16_t* MIX = wsp<bf16_t>(C, WS_MIX);
    LAS float* btab = (LAS float*)(C.lds + AT_BIAS_OFF);
    { const float* src = wsp<float>(C, WS_S5P + S5P_BIAS); for (int i = I.tid; i < 8 * BIAS_LD; i += 512) btab[i] = ((i % BIAS_LD) < 257) ? src[i] : 0.f; }
    __syncthreads();
    const int r32 = I.lane & 31, hi = I.lane >> 5, hh = I.wave >> 1, qh = I.wave & 1;
    for (int it = blockIdx.x; it < NB * 128 * 2; it += gridDim.x) {
        const int hg = it & 1, c = (it >> 1) & 127, b = it >> 8, h = hg * 4 + hh;
        const int q0 = c * 64 + qh * 32, kc0 = (c >= 8) ? c - 8 : 0, nt = c - kc0 + 1;
        const size_t rowq = (size_t)b * SEQ + q0 + r32;
        const bf16_t* kbase = proj + ((size_t)b * SEQ + kc0 * 64) * 1536 + 512 + hg * 256; const bf16_t* vbase = VT + (size_t)(hg * 256) * MTOK + (size_t)b * SEQ + kc0 * 64;
        AtStage R; at_load(R, kbase, 1536, vbase, I.tid);
        bf16x8 qr[4];
#pragma unroll
        for (int d0 = 0; d0 < 4; ++d0) qr[d0] = *(const bf16x8*)(proj + rowq * 1536 + h * 64 + d0 * 16 + 8 * hi);
        at_store(R, C.lds, I.tid);
        __syncthreads();
        const LAS float* tb = btab + h * BIAS_LD;
        f32x16 o[2]; o[0] = (f32x16){0.f, 0.f, 0.f, 0.f, 0.f, 0.f, 0.f, 0.f, 0.f, 0.f, 0.f, 0.f, 0.f, 0.f, 0.f, 0.f}; o[1] = o[0];
        float m = -1e30f, l = 0.f;
        const int qpos = q0 + r32;
#pragma unroll 1
        for (int t = 0; t < nt; ++t) {
            const int kb = (kc0 + t) * 64; const bool has_next = (t + 1 < nt);
            if (has_next) at_load(R, kbase + (size_t)(t + 1) * 64 * 1536, 1536, vbase + (t + 1) * 64, I.tid);
            const LAS unsigned char* st = C.lds + (t & 1) * AT_STAGEB + hh * AT_HEADB;
            const LAS unsigned char* kp = st + r32 * AT_ROWB + hi * 16;
            f32x16 p0 = qk32_lds(kp, qr), p1 = qk32_lds(kp + 32 * AT_ROWB, qr);
            float mx = -1e30f;
#pragma unroll
            for (int r = 0; r < 16; ++r) { const int d0 = qpos - (kb + crow(r, hi)); const int i0 = min(max(d0, -128), 128) + 128, i1 = min(max(d0 - 32, -128), 128) + 128;
                p0[r] += tb[i0]; p1[r] += tb[i1]; mx = fmaxf(mx, fmaxf(p0[r], p1[r])); }
            { float up; const float lo = half_lo(mx, up); mx = fmaxf(lo, up); }
            const float mn = fmaxf(m, mx), alpha = fast_exp2(m - mn); m = mn;
            float ls = 0.f;
#pragma unroll
            for (int r = 0; r < 16; ++r) { p0[r] = fast_exp2(p0[r] - mn); p1[r] = fast_exp2(p1[r] - mn); ls += p0[r] + p1[r]; }
            l = l * alpha + ls;
#pragma unroll
            for (int r = 0; r < 16; ++r) { o[0][r] *= alpha; o[1][r] *= alpha; }
            pv64_lds(o, st + 9216 + r32 * AT_ROWB + hi * 8, p0, p1);
            if (has_next) at_store(R, C.lds + ((t + 1) & 1) * AT_STAGEB, I.tid);
            __syncthreads();
        }
        { float up; const float lo = half_lo(l, up); l = lo + up; }
        store_ot(MIX + rowq * DM + h * 64, o, fast_rcp(l), hi);
    }
}

__device__ __forceinline__ void sb_suffix(f32x16& v, float& carry, int hi) {
    float tot[4], oth[4];
#pragma unroll
    for (int a = 0; a < 4; ++a) { const float s3 = v[4 * a + 3], s2 = v[4 * a + 2] + s3, s1 = v[4 * a + 1] + s2, s0 = v[4 * a] + s1; v[4 * a + 3] = s3; v[4 * a + 2] = s2; v[4 * a + 1] = s1; v[4 * a] = s0;
        float up; const float lo = half_lo(s0, up); tot[a] = lo + up; oth[a] = up; }
    float T = carry;
#pragma unroll
    for (int a = 3; a >= 0; --a) { const float base = T + (hi == 0 ? oth[a] : 0.f); v[4 * a] += base; v[4 * a + 1] += base; v[4 * a + 2] += base; v[4 * a + 3] += base; T += tot[a]; }
    carry = T;
}
__device__ __forceinline__ void phase_sb_attn(const Ctx& C) {
    const Ids I = phase_ids();
    const bf16_t* proj = wsp<bf16_t>(C, WS_PROJ); const bf16_t* VT = wsp<bf16_t>(C, WS_VT); bf16_t* MIX = wsp<bf16_t>(C, WS_MIX);
    const int r32 = I.lane & 31, hi = I.lane >> 5, hh = I.wave >> 1, qh = I.wave & 1;
    for (int it = blockIdx.x; it < NB * 128 * 4; it += gridDim.x) {
        const int hg = it & 3, qb = 127 - ((it >> 2) & 127), b = it >> 9, h = hg * 4 + hh;
        const int q0 = qb * 64 + qh * 32, tq = q0 + r32;
        const size_t rowq = (size_t)b * SEQ + q0 + r32;
        const bf16_t* kbase = proj + ((size_t)b * SEQ + qb * 64) * 2048 + 1024 + hg * 256; const bf16_t* vbase = VT + (size_t)(hg * 256) * MTOK + (size_t)b * SEQ + qb * 64;
        AtStage R; at_load(R, kbase, 2048, vbase, I.tid);
        bf16x8 qr[4];
#pragma unroll
        for (int d0 = 0; d0 < 4; ++d0) qr[d0] = *(const bf16x8*)(proj + rowq * 2048 + h * 64 + d0 * 16 + 8 * hi);
        at_store(R, C.lds, I.tid);
        __syncthreads();
        f32x16 o[2]; o[0] = (f32x16){0.f, 0.f, 0.f, 0.f, 0.f, 0.f, 0.f, 0.f, 0.f, 0.f, 0.f, 0.f, 0.f, 0.f, 0.f, 0.f}; o[1] = o[0];
        float carry = 0.f;
#pragma unroll 1
        for (int t = 0;; ++t) {
            const int kb = (qb - t) * 64; const bool has_next = (kb >= 64);
            if (has_next) at_load(R, kbase - (size_t)(t + 1) * 64 * 2048, 2048, vbase - (t + 1) * 64, I.tid);
            const LAS unsigned char* st = C.lds + (t & 1) * AT_STAGEB + hh * AT_HEADB;
            const LAS unsigned char* kp = st + r32 * AT_ROWB + hi * 16;
            f32x16 z0 = qk32_lds(kp, qr), z1 = qk32_lds(kp + 32 * AT_ROWB, qr);
            f32x16 s0, s1;
#pragma unroll
            for (int r = 0; r < 16; ++r) { const int k0 = kb + crow(r, hi);
                const float a0 = z0[r], a1 = z1[r];
                const float sp0 = fmaxf(a0, 0.f) + fast_log2(1.0f + fast_exp2(-fabsf(a0))), sp1 = fmaxf(a1, 0.f) + fast_log2(1.0f + fast_exp2(-fabsf(a1)));
                s0[r] = (k0 < tq) ? sp0 : 0.f; s1[r] = (k0 + 32 < tq) ? sp1 : 0.f; }
            sb_suffix(s1, carry, hi); sb_suffix(s0, carry, hi);
#pragma unroll
            for (int r = 0; r < 16; ++r) { const int k0 = kb + crow(r, hi);
                z0[r] = (k0 < tq) ? fast_exp2(z0[r] - s0[r]) : 0.f; z1[r] = (k0 + 32 < tq) ? fast_exp2(z1[r] - s1[r]) : 0.f; }
            pv64_lds(o, st + 9216 + r32 * AT_ROWB + hi * 8, z0, z1);
            if (has_next) at_store(R, C.lds + ((t + 1) & 1) * AT_STAGEB, I.tid);
            const int done = __syncthreads_and(carry >= 150.0f);
            if (!has_next || done) break;
        }
        store_ot(MIX + rowq * DM + h * 64, o, 1.0f, hi);
    }
}

struct Params { const float* in[23]; float* out; unsigned char* ws; };
#define GSYNC() xcd_barrier(bar)
template <int K, class Epi> __device__ __forceinline__ void run_gemm(const Ctx& C, const bf16_t* A, const bf16_t* Bt, int M, int N, const Epi& E) {
    pg8::Gemm g{A, Bt, M, N, K}; pg8::StaticOrder S; S.init(M, N, (int)gridDim.x, (int)blockIdx.x);
    pg8::gemm_phase<Epi, pg8::StaticOrder, true, true, K>(C.lds, g, S, E);
}
__global__ void __launch_bounds__(512, 2) fwd_megakernel(Params P) {
    extern __shared__ __attribute__((aligned(16))) unsigned char lds_raw[];
    cg::grid_group grid = cg::this_grid();
    Ctx C;
#pragma unroll
    for (int i = 0; i < 23; ++i) C.in[i] = P.in[i];
    C.out = P.out; C.ws = P.ws; C.lds = (LAS unsigned char*)lds_raw;
    volatile LAS unsigned* bst = (volatile LAS unsigned*)(C.lds + LDS_CTL_OFF);
    if (threadIdx.x < 64) bst[threadIdx.x] = 0u;
    __syncthreads();
    XcdBarrier bar = xcd_barrier_post((unsigned*)C.ws + 4096, bst + 8);
    grid.sync();
    bf16_t* HB = wsp<bf16_t>(C, WS_HB); bf16_t* PROJ = wsp<bf16_t>(C, WS_PROJ); bf16_t* VT = wsp<bf16_t>(C, WS_VT); bf16_t* MIX = wsp<bf16_t>(C, WS_MIX); bf16_t* HID = wsp<bf16_t>(C, WS_HID);

    for (int rep_ = 0; rep_ < REP_PRO; ++rep_) phase_prologue(C);
    for (int rep_ = 0; rep_ < REP_SYNC; ++rep_) GSYNC();
#pragma unroll
    for (int layer = 0; layer < 2; ++layer) {
        { const int nqk = layer ? 2048 : 1536, nv = layer ? 1024 : 512;
          EpiStoreBf16 E1{PROJ, nqk, layer ? 1024 : 512, QSCALE};
          run_gemm<1024>(C, HB, wsp<bf16_t>(C, layer ? WS_WQK1 : WS_WQKU0), MTOK, nqk, E1);
          EpiStoreBf16 E2{VT, MTOK, 0, 1.0f};
          run_gemm<1024>(C, wsp<bf16_t>(C, layer ? WS_WV1 : WS_WV0), HB, nv, MTOK, E2); }
        GSYNC();
        if (layer == 0) {
            for (int rep_ = 0; rep_ < REP_S5; ++rep_) phase_s5a(C);
            GSYNC();
            phase_s5b(C);
            for (int rep_ = 0; rep_ < REP_CA; ++rep_) phase_chunk_attn(C);
            GSYNC();
            for (int rep_ = 0; rep_ < REP_S5; ++rep_) phase_s5c(C);
            GSYNC();
            { EpiGlu E{wsp<bf16_t>(C, WS_YG), C.in[12], MIX}; run_gemm<512>(C, wsp<bf16_t>(C, WS_YG), wsp<bf16_t>(C, WS_WGLU), MTOK, 512, E); }
        } else {
            for (int rep_ = 0; rep_ < REP_SB; ++rep_) phase_sb_attn(C);
        }
        GSYNC();
        { EpiResF32 E{layer ? C.out : C.in[0], C.out, ALPHA}; run_gemm<1024>(C, MIX, wsp<bf16_t>(C, layer ? WS_WOUT1 : WS_WOUT0), MTOK, DM, E); }
        GSYNC();
        phase_ln(C, C.out, HB, C.in[19] + layer * DM, C.in[20] + layer * DM);
        GSYNC();
        { EpiSwiglu E{HID, DFF}; run_gemm<1024>(C, HB, wsp<bf16_t>(C, layer ? WS_W13_1 : WS_W13_0), MTOK, 2 * DFF, E); }
        GSYNC();
        { EpiResF32 E{C.out, C.out, ALPHA}; run_gemm<2816>(C, HID, wsp<bf16_t>(C, layer ? WS_W2_1 : WS_W2_0), MTOK, DM, E); }
        GSYNC();
        phase_ln(C, C.out, HB, C.in[21] + layer * DM, C.in[22] + layer * DM);
        if (layer == 0) GSYNC();
    }
}

extern "C" void kernel_launch(void* const* d_in, const int* in_sizes, int n_in, void* d_out, int out_size, void* d_ws, size_t ws_size, hipStream_t stream) {
    static int grid = 0;
    if (grid == 0) {
        if (n_in != 23 || out_size != MTOK * DM || ws_size < WS_END) { fprintf(stderr, "kernel_launch: unexpected shapes (n_in %d, out %d, ws %zu)\n", n_in, out_size, ws_size); grid = -1; return; }
        int dev = 0, cus = 0, per_cu = 0;
        hipGetDevice(&dev); hipDeviceGetAttribute(&cus, hipDeviceAttributeMultiprocessorCount, dev);
        hipFuncSetAttribute((const void*)fwd_megakernel, hipFuncAttributeMaxDynamicSharedMemorySize, LDS_BYTES);
        hipOccupancyMaxActiveBlocksPerMultiprocessor(&per_cu, (const void*)fwd_megakernel, 512, LDS_BYTES);
        if (per_cu < 1) { fprintf(stderr, "kernel_launch: occupancy query says %d blocks per CU\n", per_cu); per_cu = 1; }
        grid = cus * 1;
        (void)hipGetLastError();
    }
    if (grid < 0) return;
    if (hipMemsetAsync(d_ws, 0, 1u << 20, stream) != hipSuccess) { fprintf(stderr, "kernel_launch: memset failed\n"); return; }
    Params p{};
    for (int i = 0; i < 23; ++i) p.in[i] = (const float*)d_in[i];
    p.out = (float*)d_out; p.ws = (unsigned char*)d_ws;
    void* args[] = {&p};
    hipError_t e = hipLaunchCooperativeKernel((const void*)fwd_megakernel, dim3(grid), dim3(512), args, LDS_BYTES, stream);
    if (e != hipSuccess) fprintf(stderr, "cooperative launch failed: %s (grid %d)\n", hipGetErrorString(e), grid);
}
```
